# Optimizing an MI355X kernel written in HIP

```python
import jax, jax.numpy as jnp
from jax import lax
import numpy as np

D_MODEL = 1024
BATCH = 16
SEQ = 4096
DEPTH = 1

HEAD_DIM = 64
N_ATTN_HEADS = 8
N_KV_HEADS = 2
GQA_GROUP = N_ATTN_HEADS // N_KV_HEADS
ATTN_WIDTH = N_ATTN_HEADS * HEAD_DIM
KV_WIDTH = N_KV_HEADS * HEAD_DIM
N_RWKV_HEADS = 8
RWKV_WIDTH = N_RWKV_HEADS * HEAD_DIM
MIX_WIDTH = ATTN_WIDTH + RWKV_WIDTH
WINDOW = 128
BLOCK = 128
DECAY_LORA = 64
ICLR_LORA = 64
GATE_LORA = 128
RWKV_SHIFT_WIDTH = 3 * RWKV_WIDTH + DECAY_LORA + ICLR_LORA + GATE_LORA
IN_WIDTH = ATTN_WIDTH + 2 * KV_WIDTH + RWKV_SHIFT_WIDTH
D_FF = 4 * D_MODEL
RMS_EPS = 1e-6
GN_EPS = 64e-5
L2_EPS = 1e-12
NEG_INF = -1e30

kernel_name = 'hybrid_swa_sink_alibi_rwkv7_block'


def rms_norm(x, g):
    xf = x.astype(jnp.float32)
    y = xf * lax.rsqrt(jnp.mean(xf * xf, axis=-1, keepdims=True) + RMS_EPS)
    return (y * g.astype(jnp.float32)).astype(x.dtype)


def alibi_slopes():
    h = jnp.arange(1, N_ATTN_HEADS + 1, dtype=jnp.float32)
    return jnp.exp2(-8.0 * h / N_ATTN_HEADS)


def sliding_window_attention(q, k, v, sinks):
    B, T = q.shape[0], q.shape[1]
    nb = T // BLOCK
    qb = q.reshape(B, nb, BLOCK, N_KV_HEADS, GQA_GROUP, HEAD_DIM)

    def band(t):
        tp = jnp.pad(t, ((0, 0), (BLOCK, 0), (0, 0), (0, 0)))
        tp = tp.reshape(B, nb + 1, BLOCK, N_KV_HEADS, HEAD_DIM)
        return jnp.concatenate([tp[:, :-1], tp[:, 1:]], axis=2)

    kb, vb = band(k), band(v)
    s = jnp.einsum('bnqkgd,bnskd->bnkgqs', qb, kb).astype(jnp.float32) * (HEAD_DIM ** -0.5)
    qi = jnp.arange(BLOCK)[:, None]
    kj = jnp.arange(2 * BLOCK)[None, :]
    dist = qi - kj + BLOCK
    bias = -alibi_slopes().reshape(N_KV_HEADS, GQA_GROUP, 1, 1) * dist.astype(jnp.float32)
    key_pos = jnp.arange(nb)[:, None] * BLOCK + jnp.arange(2 * BLOCK)[None, :] - BLOCK
    valid = ((dist >= 0) & (dist < WINDOW))[None] & (key_pos >= 0)[:, None, :]
    s = jnp.where(valid[None, :, None, None], s + bias, NEG_INF)
    sink = sinks.astype(jnp.float32).reshape(1, 1, N_KV_HEADS, GQA_GROUP, 1, 1)
    m = jnp.maximum(jnp.max(s, axis=-1, keepdims=True), sink)
    e = jnp.exp(s - m)
    p = e / (jnp.sum(e, axis=-1, keepdims=True) + jnp.exp(sink - m))
    o = jnp.einsum('bnkgqs,bnskd->bnqkgd', p.astype(vb.dtype), vb)
    return o.reshape(B, T, ATTN_WIDTH)


def rwkv7_recurrence(r, w, k, v, a, b):
    B, _, H, N = r.shape

    def step(S, inp):
        rt, wt, kt, vt, at, bt = inp
        sa = jnp.einsum('bhij,bhj->bhi', S, at)
        S = S * wt[:, :, None, :] + sa[..., None] * bt[:, :, None, :] + vt[..., None] * kt[:, :, None, :]
        return S, jnp.einsum('bhij,bhj->bhi', S, rt)

    xs = tuple(jnp.moveaxis(t, 1, 0) for t in (r, w, k, v, a, b))
    S0 = jnp.zeros((B, H, N, N), jnp.float32)
    _, y = lax.scan(step, S0, xs)
    return jnp.moveaxis(y, 0, 1)


def rwkv7_time_mix(xr, xk, xv, xw, xa, xg, w0, w2, a0, a2, g2, k_k, k_a, r_k, ln_w, ln_b):
    out_dtype = xr.dtype
    f = lambda t: t.astype(jnp.float32)
    xr, xk, xv, xw, xa, xg = f(xr), f(xk), f(xv), f(xw), f(xa), f(xg)
    B, T, _ = xr.shape
    heads = lambda t: t.reshape(B, T, N_RWKV_HEADS, HEAD_DIM)
    w_log = -jax.nn.softplus(-(f(w0) + jnp.tanh(xw) @ f(w2))) - 0.5
    decay = jnp.exp(-jnp.exp(w_log))
    a = jax.nn.sigmoid(f(a0) + xa @ f(a2))
    g = jax.nn.sigmoid(xg) @ f(g2)
    kk = heads(xk * f(k_k))
    kk = kk / jnp.maximum(jnp.sqrt(jnp.sum(kk * kk, axis=-1, keepdims=True)), L2_EPS)
    k = xk * (1.0 + (a - 1.0) * f(k_a))
    r_h, k_h, v_h, a_h = heads(xr), heads(k), heads(xv), heads(a)
    y = rwkv7_recurrence(r_h, heads(decay), k_h, v_h, -kk, kk * a_h)
    mu = jnp.mean(y, axis=-1, keepdims=True)
    var = jnp.mean(jnp.square(y - mu), axis=-1, keepdims=True)
    y = ((y - mu) * lax.rsqrt(var + GN_EPS)).reshape(B, T, RWKV_WIDTH) * f(ln_w) + f(ln_b)
    bonus = jnp.sum(r_h * k_h * f(r_k).reshape(N_RWKV_HEADS, HEAD_DIM), axis=-1, keepdims=True) * v_h
    y = (y + bonus.reshape(B, T, RWKV_WIDTH)) * g
    return y.astype(out_dtype)


def setup_inputs(seed: int = 0) -> dict:
    key = jax.random.key(seed)
    ks = jax.random.split(key, 20)
    f32 = jnp.float32
    L = DEPTH

    def nrm(k, shape, scale):
        return jax.random.normal(k, shape, f32) * scale

    return {
        'x': nrm(ks[0], (BATCH, SEQ, D_MODEL), 1.0),
        'attn_norm_g': 1.0 + nrm(ks[1], (L, D_MODEL), 0.02),
        'w_in': nrm(ks[2], (L, D_MODEL, IN_WIDTH), D_MODEL ** -0.5),
        'attn_sinks': nrm(ks[3], (L, N_ATTN_HEADS), 1.0),
        'rwkv_mu': jax.random.uniform(ks[4], (L, RWKV_SHIFT_WIDTH), f32),
        'w0': jax.random.uniform(ks[5], (L, RWKV_WIDTH), f32, -4.0, 0.0),
        'w2': nrm(ks[6], (L, DECAY_LORA, RWKV_WIDTH), 0.5 * DECAY_LORA ** -0.5),
        'a0': nrm(ks[7], (L, RWKV_WIDTH), 0.1),
        'a2': nrm(ks[8], (L, ICLR_LORA, RWKV_WIDTH), ICLR_LORA ** -0.5),
        'g2': nrm(ks[9], (L, GATE_LORA, RWKV_WIDTH), GATE_LORA ** -0.5),
        'k_k': 0.85 + nrm(ks[10], (L, RWKV_WIDTH), 0.02),
        'k_a': 1.0 + nrm(ks[11], (L, RWKV_WIDTH), 0.02),
        'r_k': nrm(ks[12], (L, RWKV_WIDTH), 0.1),
        'ln_x_w': 1.0 + nrm(ks[13], (L, RWKV_WIDTH), 0.02),
        'ln_x_b': nrm(ks[14], (L, RWKV_WIDTH), 0.02),
        'w_out': nrm(ks[15], (L, MIX_WIDTH, D_MODEL), MIX_WIDTH ** -0.5),
        'mlp_norm_g': 1.0 + nrm(ks[16], (L, D_MODEL), 0.02),
        'w_up': nrm(ks[17], (L, D_MODEL, D_FF), D_MODEL ** -0.5),
        'w_down': nrm(ks[18], (L, D_FF, D_MODEL), D_FF ** -0.5),
        'final_norm_g': 1.0 + nrm(ks[19], (D_MODEL,), 0.02),
    }


def reference(x, attn_norm_g, w_in, attn_sinks, rwkv_mu, w0, w2, a0, a2, g2, k_k, k_a, r_k,
              ln_x_w, ln_x_b, w_out, mlp_norm_g, w_up, w_down, final_norm_g):
    B, T, _ = x.shape
    c1 = ATTN_WIDTH
    c2 = c1 + KV_WIDTH
    c3 = c2 + KV_WIDTH
    r1 = RWKV_WIDTH
    r2 = 2 * RWKV_WIDTH
    r3 = 3 * RWKV_WIDTH
    r4 = r3 + DECAY_LORA
    r5 = r4 + ICLR_LORA
    for l in range(DEPTH):
        h = rms_norm(x, attn_norm_g[l])
        z = h @ w_in[l]
        q = z[..., :c1].reshape(B, T, N_ATTN_HEADS, HEAD_DIM)
        ka = z[..., c1:c2].reshape(B, T, N_KV_HEADS, HEAD_DIM)
        va = z[..., c2:c3].reshape(B, T, N_KV_HEADS, HEAD_DIM)
        attn_out = sliding_window_attention(q, ka, va, attn_sinks[l])
        zr = z[..., c3:]
        zr_prev = jnp.pad(zr, ((0, 0), (1, 0), (0, 0)))[:, :-1]
        zs = zr + (zr_prev - zr) * rwkv_mu[l]
        rwkv_out = rwkv7_time_mix(zs[..., :r1], zs[..., r1:r2], zs[..., r2:r3],
                                  zs[..., r3:r4], zs[..., r4:r5], zs[..., r5:],
                                  w0[l], w2[l], a0[l], a2[l], g2[l], k_k[l], k_a[l], r_k[l],
                                  ln_x_w[l], ln_x_b[l])
        x = x + jnp.concatenate([attn_out, rwkv_out], axis=-1) @ w_out[l]
        h = rms_norm(x, mlp_norm_g[l])
        x = x + jnp.square(jax.nn.relu(h @ w_up[l])) @ w_down[l]
    return rms_norm(x, final_norm_g)
```

```cpp
#include <hip/hip_runtime.h>
#include <hip/hip_cooperative_groups.h>
#include <cstdio>
#include <cstdint>
namespace cg = cooperative_groups;
namespace pg8 {
#define PG8_LAS __attribute__((address_space(3)))
typedef unsigned short bf16_t;
typedef short bf16x8 __attribute__((ext_vector_type(8)));
typedef float f32x4 __attribute__((ext_vector_type(4)));
typedef unsigned u32x4 __attribute__((ext_vector_type(4)));
constexpr int BM = 256, BK = 64, HALF = 128, HTB = HALF * BK * 2  , STAGE_BYTES = 8 * HTB, NXCD = 8, WGM = 8;

__host__ __device__ __forceinline__ int lds_byte(int r, int c) { const int st = (r >> 4) * 2 + (c >> 5), rr = r & 15, cc = c & 31, ob = rr * 64 + cc * 2; return st * 1024 + (ob ^ (((ob >> 9) & 1) << 5)); }
__host__ __device__ __forceinline__ void stage_rc(int b, int& R, int& C) { const int st = b / 1024, sb = b % 1024, swz = sb ^ (((sb >> 9) & 1) << 5); R = (st >> 1) * 16 + swz / 64; C = (st & 1) * 32 + (swz % 64) / 2; }
__host__ __device__ __forceinline__ int perm32(int rho) { const int n = rho >> 4, i = rho & 15; return 8 * (i >> 2) + 4 * n + (i & 3); }

struct Unit { int pm, pn; };
struct Gemm { const bf16_t* A; const bf16_t* Bt; int M, N, K; };

struct StaticOrder {
    int nM, nN, nwg, G, c;
    __host__ __device__ void init(int M, int N, int G_, int c_) { nM = M / BM; nN = N / BM; nwg = nM * nN; G = G_; c = c_; }
    __host__ __device__ bool next(int i, Unit& u) const {
        const long L = (long)i * G + c; if (L >= nwg) return false;
        int wgid = (int)L; { const int q = nwg / NXCD, r = nwg % NXCD, xcd = wgid % NXCD, off = wgid / NXCD; wgid = (xcd < r ? xcd * (q + 1) : r * (q + 1) + (xcd - r) * q) + off; }
        const int nig = WGM * nN, gid = wgid / nig, fm = gid * WGM, gsz = (nM - fm) < WGM ? (nM - fm) : WGM;
        u.pm = fm + ((wgid % nig) % gsz); u.pn = (wgid % nig) / gsz; return true;
    }
    __device__ __forceinline__ void a_ready(const Unit&) const {}
    __device__ __forceinline__ void done(const Unit&) const {}
};

__device__ __forceinline__ unsigned cvt_pk_bf16(float lo, float hi) { unsigned r; asm volatile("v_cvt_pk_bf16_f32 %0, %1, %2" : "=v"(r) : "v"(lo), "v"(hi)); return r; }
template <int ACT  > struct EpiBf16 {
    static constexpr bool PERM = true, AFTER_DRAIN = false; static_assert(ACT == 0 || ACT == 2, "EpiBf16: ACT is 0 (none) or 2 (relu squared)");
    bf16_t* O; int ldc; const float* bias; int split_cols; size_t split_stride; float scale0;
    __device__ __forceinline__ void operator()(const f32x4 (&acc)[2][2][4][2], const Unit& u, int wr, int wc, int fr, int fq) const {
        const int row0 = u.pm * BM + wr * 64 + fr; int colt = u.pn * BM; bf16_t* base = O;
        float sc = 1.f; if (split_cols) { const int t = colt / split_cols; base += (size_t)t * split_stride; colt -= t * split_cols; if (t == 0) sc = scale0; }
        const int col0 = colt + wc * 32 + 8 * fq, bcol0 = u.pn * BM + wc * 32 + 8 * fq;
        f32x4 bv[2][2];
#pragma unroll
        for (int bj = 0; bj < 2; ++bj)
#pragma unroll
            for (int n = 0; n < 2; ++n) bv[bj][n] = bias ? *(const f32x4*)(bias + bcol0 + bj * HALF + 4 * n) : (f32x4){0.f, 0.f, 0.f, 0.f};
#pragma unroll
        for (int ai = 0; ai < 2; ++ai)
#pragma unroll
            for (int m = 0; m < 4; ++m) { bf16_t* rowp = base + (size_t)(row0 + ai * HALF + m * 16) * ldc + col0;
#pragma unroll
                for (int bj = 0; bj < 2; ++bj) { f32x4 v0 = acc[ai][bj][m][0] + bv[bj][0], v1 = acc[ai][bj][m][1] + bv[bj][1];
                    if (ACT == 2) { v0 = __builtin_elementwise_max(v0, (f32x4){0.f, 0.f, 0.f, 0.f}); v1 = __builtin_elementwise_max(v1, (f32x4){0.f, 0.f, 0.f, 0.f}); v0 = v0 * v0; v1 = v1 * v1; }
                    v0 = v0 * sc; v1 = v1 * sc; u32x4 w; w.x = cvt_pk_bf16(v0[0], v0[1]); w.y = cvt_pk_bf16(v0[2], v0[3]); w.z = cvt_pk_bf16(v1[0], v1[1]); w.w = cvt_pk_bf16(v1[2], v1[3]);
                    *(u32x4*)(rowp + bj * HALF) = w; } }
    }
};
struct EpiResF32 {
    static constexpr bool PERM = false, AFTER_DRAIN = false;
    const float* base; float* out; int ldc;
    __device__ __forceinline__ void operator()(const f32x4 (&acc)[2][2][4][2], const Unit& u, int wr, int wc, int fr, int fq) const {
        const int col0 = u.pn * BM + wc * 32 + 4 * fq;
#pragma unroll
        for (int ai = 0; ai < 2; ++ai)
#pragma unroll
            for (int m = 0; m < 4; ++m) { const int r = ai * HALF + wr * 64 + m * 16 + fr; const size_t off = (size_t)(u.pm * BM + r) * ldc + col0;
#pragma unroll
                for (int bj = 0; bj < 2; ++bj)
#pragma unroll
                    for (int n = 0; n < 2; ++n) { const f32x4 bs = *(const f32x4*)(base + off + bj * HALF + n * 16); const f32x4 o = bs + acc[ai][bj][m][n]; *(f32x4*)(out + off + bj * HALF + n * 16) = o; }
                if (m & 1) asm volatile("" ::: "memory"); }
    }
};
struct PanelOrder {
    int pm, nN;
    __device__ __forceinline__ bool next(int i, Unit& u) const { if (i >= nN) return false; u.pm = pm; u.pn = i; return true; }
    __device__ __forceinline__ void a_ready(const Unit&) const {}
    __device__ __forceinline__ void done(const Unit&) const {}
};
struct TeamOrder {
    int pm0, pstride, pn0, np, nt;
    __device__ __forceinline__ bool next(int i, Unit& u) const { if (i >= np * nt) return false; u.pm = pm0 + (i / nt) * pstride; u.pn = pn0 + (i % nt); return true; }
    __device__ __forceinline__ void a_ready(const Unit&) const {}
    __device__ __forceinline__ void done(const Unit&) const {}
};
template <class Epi, class Sched, bool ALIGN_EPI = false, bool SP2 = false>
__device__ __forceinline__ void gemm_phase(PG8_LAS unsigned char* lds, const Gemm g, const Sched& S, const Epi& E) {
    int tid_ = threadIdx.x; asm volatile("" : "+v"(tid_));
    const int tid = tid_, wid = __builtin_amdgcn_readfirstlane(tid >> 6), lane = tid & 63, wr = wid >> 2, wc = wid & 3, fr = lane & 15, fq = lane >> 4;
    const int K = g.K, nt = K / BK;
    unsigned voffA[2], voffB[2];
#pragma unroll
    for (int i = 0; i < 2; ++i) { int R, C; stage_rc(tid * 16 + i * 8192, R, C); const int Rb = Epi::PERM ? ((R & ~31) + perm32(R & 31)) : R;
        voffA[i] = (unsigned)(R * K + C) * 2u; voffB[i] = (unsigned)(Rb * K + C) * 2u; }
    const size_t kstep = (size_t)(BK * 2);
    const size_t hstep = (size_t)HALF * K * 2;
    const size_t tstep = 2 * hstep;
    const unsigned ldsw = (unsigned)wid * 1024u;
    const int aoff = lds_byte(wr * 64 + fr, fq * 8), boff = lds_byte(wc * 32 + fr, fq * 8);
#define PG8_SA(b, h) (((b) * 2 + (h)) * HTB)
#define PG8_SB(b, h) ((4 + (b) * 2 + (h)) * HTB)
#define PG8_STAGE(bufoff, gbase, voff) do { _Pragma("unroll") for (int _i = 0; _i < 2; ++_i) \
        __builtin_amdgcn_global_load_lds((const unsigned*)((const char*)(gbase) + (voff)[_i]), (PG8_LAS unsigned*)(lds + (bufoff) + ldsw + _i * 8192), 16, 0, 0); } while (0)
#define PG8_LDA(dst, b, h) do { _Pragma("unroll") for (int m = 0; m < 4; ++m) _Pragma("unroll") for (int k = 0; k < 2; ++k) dst[m][k] = *(const PG8_LAS bf16x8*)(lds + PG8_SA(b, h) + aoff + m * 2048 + k * 1024); } while (0)
#define PG8_LDB(dst, b, h) do { _Pragma("unroll") for (int n = 0; n < 2; ++n) _Pragma("unroll") for (int k = 0; k < 2; ++k) dst[n][k] = *(const PG8_LAS bf16x8*)(lds + PG8_SB(b, h) + boff + n * 2048 + k * 1024); } while (0)
#define PG8_MMA(ai, bj, At, Bt) do { __builtin_amdgcn_s_setprio(1); _Pragma("unroll") for (int m = 0; m < 4; ++m) _Pragma("unroll") for (int n = 0; n < 2; ++n) _Pragma("unroll") for (int k = 0; k < 2; ++k) \
        acc[ai][bj][m][n] = __builtin_amdgcn_mfma_f32_16x16x32_bf16(Bt[n][k], At[m][k], acc[ai][bj][m][n], 0, 0, 0); __builtin_amdgcn_s_setprio(0); } while (0)
#define PG8_WAIT_V(n) asm volatile("s_waitcnt vmcnt(" #n ")" ::: "memory")
#define PG8_WAIT_L(n) asm volatile("s_waitcnt lgkmcnt(" #n ")" ::: "memory")
#define PG8_BAR __builtin_amdgcn_s_barrier()
#define PG8_SCHED __builtin_amdgcn_sched_barrier(0)
    Unit cur, nxt; int ui = 0;
    if (!S.next(0, cur)) return;
    f32x4 acc[2][2][4][2];
#pragma unroll
    for (int a = 0; a < 2; ++a)
#pragma unroll
        for (int b = 0; b < 2; ++b)
#pragma unroll
            for (int m = 0; m < 4; ++m)
#pragma unroll
                for (int n = 0; n < 2; ++n) acc[a][b][m][n] = (f32x4){0.f, 0.f, 0.f, 0.f};
    bf16x8 At[4][2], B0[2][2], B1[2][2];
    const char* cA = (const char*)g.A + (size_t)cur.pm * tstep; const char* cB = (const char*)g.Bt + (size_t)cur.pn * tstep;
    S.a_ready(cur);
    if constexpr (SP2) {
        PG8_STAGE(PG8_SB(0, 0), cB, voffB); PG8_STAGE(PG8_SB(0, 1), cB + hstep, voffB); PG8_STAGE(PG8_SA(0, 0), cA, voffA); PG8_STAGE(PG8_SA(0, 1), cA + hstep, voffA);
        if (wr == 1) PG8_BAR;
        PG8_WAIT_V(2); PG8_BAR;
        PG8_STAGE(PG8_SB(1, 0), cB + kstep, voffB); PG8_STAGE(PG8_SA(1, 0), cA + kstep, voffA); PG8_STAGE(PG8_SB(1, 1), cB + hstep + kstep, voffB);
        PG8_WAIT_V(6); PG8_BAR;
    } else {
        PG8_STAGE(PG8_SB(0, 0), cB, voffB); PG8_STAGE(PG8_SA(0, 0), cA, voffA); PG8_STAGE(PG8_SB(0, 1), cB + hstep, voffB); PG8_STAGE(PG8_SA(0, 1), cA + hstep, voffA);
        if (wr == 1) PG8_BAR;
        PG8_WAIT_V(4); PG8_BAR;
        PG8_STAGE(PG8_SB(1, 0), cB + kstep, voffB); PG8_STAGE(PG8_SA(1, 0), cA + kstep, voffA); PG8_STAGE(PG8_SB(1, 1), cB + hstep + kstep, voffB);
        PG8_WAIT_V(6); PG8_BAR;
    }
    for (;;) {
        const bool has_next = S.next(ui + 1, nxt);
        const char* nA = has_next ? (const char*)g.A + (size_t)nxt.pm * tstep : cA; const char* nB = has_next ? (const char*)g.Bt + (size_t)nxt.pn * tstep : cB;
#pragma nounroll
        for (int t = 0; t < nt; t += 2) {
            const bool last = (t == nt - 2);
            const char* a1 = cA + (size_t)(t + 1) * kstep;
            const char* a2 = last ? nA : cA + (size_t)(t + 2) * kstep; const char* b2 = last ? nB : cB + (size_t)(t + 2) * kstep;
            const char* a3 = a2 + kstep; const char* b3 = b2 + kstep;
            if (last && has_next) S.a_ready(nxt);
            if constexpr (SP2) {
            PG8_LDB(B0, 0, 0); PG8_LDB(B1, 0, 1); PG8_SCHED; PG8_LDA(At, 0, 0); PG8_STAGE(PG8_SA(1, 1), a1 + hstep, voffA);
            PG8_WAIT_V(8); PG8_WAIT_L(0); PG8_BAR; PG8_MMA(0, 0, At, B0); PG8_MMA(0, 1, At, B1); PG8_BAR; PG8_SCHED;
            PG8_LDA(At, 0, 1); PG8_STAGE(PG8_SB(0, 0), b2, voffB); PG8_STAGE(PG8_SB(0, 1), b2 + hstep, voffB); PG8_STAGE(PG8_SA(0, 0), a2, voffA);
            PG8_WAIT_V(8); PG8_WAIT_L(0); PG8_BAR; PG8_MMA(1, 0, At, B0); PG8_MMA(1, 1, At, B1); PG8_BAR; PG8_SCHED;
            PG8_LDB(B0, 1, 0); PG8_LDB(B1, 1, 1); PG8_SCHED; PG8_LDA(At, 1, 0); PG8_STAGE(PG8_SA(0, 1), a2 + hstep, voffA);
            PG8_WAIT_V(8); PG8_WAIT_L(0); PG8_BAR; PG8_MMA(0, 0, At, B0); PG8_MMA(0, 1, At, B1); PG8_BAR; PG8_SCHED;
            PG8_LDA(At, 1, 1); PG8_STAGE(PG8_SB(1, 0), b3, voffB); PG8_STAGE(PG8_SB(1, 1), b3 + hstep, voffB); PG8_STAGE(PG8_SA(1, 0), a3, voffA);
            PG8_WAIT_V(8); PG8_WAIT_L(0); PG8_BAR; PG8_MMA(1, 0, At, B0); PG8_MMA(1, 1, At, B1); PG8_BAR; PG8_SCHED;
            } else {
            PG8_LDB(B0, 0, 0); PG8_SCHED; PG8_LDA(At, 0, 0); PG8_STAGE(PG8_SA(1, 1), a1 + hstep, voffA);
            PG8_WAIT_L(8); PG8_BAR; PG8_WAIT_L(0); PG8_MMA(0, 0, At, B0); PG8_BAR; PG8_SCHED;
            PG8_LDB(B1, 0, 1); PG8_STAGE(PG8_SB(0, 0), b2, voffB);
            PG8_BAR; PG8_WAIT_L(0); PG8_MMA(0, 1, At, B1); PG8_BAR;
            PG8_LDA(At, 0, 1); PG8_STAGE(PG8_SA(0, 0), a2, voffA);
            PG8_BAR; PG8_WAIT_L(0); PG8_MMA(1, 0, At, B0); PG8_BAR; PG8_SCHED;
            PG8_STAGE(PG8_SB(0, 1), b2 + hstep, voffB);
            PG8_WAIT_V(6); PG8_BAR; PG8_MMA(1, 1, At, B1); PG8_BAR;
            PG8_LDB(B0, 1, 0); PG8_SCHED; PG8_LDA(At, 1, 0); PG8_STAGE(PG8_SA(0, 1), a2 + hstep, voffA);
            PG8_WAIT_L(8); PG8_BAR; PG8_WAIT_L(0); PG8_MMA(0, 0, At, B0); PG8_BAR; PG8_SCHED;
            PG8_LDB(B1, 1, 1); PG8_STAGE(PG8_SB(1, 0), b3, voffB);
            PG8_BAR; PG8_WAIT_L(0); PG8_MMA(0, 1, At, B1); PG8_BAR;
            PG8_LDA(At, 1, 1); PG8_STAGE(PG8_SA(1, 0), a3, voffA);
            PG8_BAR; PG8_WAIT_L(0); PG8_MMA(1, 0, At, B0); PG8_BAR; PG8_SCHED;
            PG8_STAGE(PG8_SB(1, 1), b3 + hstep, voffB);
            PG8_WAIT_V(6); PG8_BAR; PG8_MMA(1, 1, At, B1); PG8_BAR;
            }
        }
        if constexpr (ALIGN_EPI) { if (wr == 0) PG8_BAR; }
        if constexpr (!Epi::AFTER_DRAIN) { E(acc, cur, wr, wc, fr, fq); S.done(cur); }
        if (!has_next) break;
#pragma unroll
        for (int a = 0; a < 2; ++a)
#pragma unroll
            for (int b = 0; b < 2; ++b)
#pragma unroll
                for (int m = 0; m < 4; ++m)
#pragma unroll
                    for (int n = 0; n < 2; ++n) acc[a][b][m][n] = (f32x4){0.f, 0.f, 0.f, 0.f};
        cur = nxt; cA = nA; cB = nB; ++ui;
        if constexpr (ALIGN_EPI) { if (wr == 1) PG8_BAR; }
    }
    PG8_WAIT_V(0);
    if constexpr (!ALIGN_EPI) { if (wr == 0) PG8_BAR; }
    PG8_BAR;
    if constexpr (Epi::AFTER_DRAIN) { E.fused(acc, cur, wr, wc, fr, fq, lds, wid, lane); S.done(cur); }
#undef PG8_SA
#undef PG8_SB
#undef PG8_STAGE
#undef PG8_LDA
#undef PG8_LDB
#undef PG8_MMA
#undef PG8_WAIT_V
#undef PG8_WAIT_L
#undef PG8_BAR
#undef PG8_SCHED
}
}
#ifndef REP_SCAN
#define REP_SCAN 1
#endif
#ifndef REP_ATTN
#define REP_ATTN 1
#endif
#ifndef REP_HELP
#define REP_HELP 1
#endif
#ifndef REP_P4
#define REP_P4 1
#endif
#ifndef REP_P1
#define REP_P1 1
#endif
#ifndef REP_P2
#define REP_P2 1
#endif
#ifndef REP_CHAIN
#define REP_CHAIN 1
#endif
#ifndef PG8_SP2
#define PG8_SP2 true
#endif
#ifndef PG8_ALIGN
#define PG8_ALIGN true
#endif
constexpr int NWAVES = 8;
constexpr int BATCH = 16, T = 4096, D = 1024, M = BATCH * T;
constexpr int INW = 2560, FF = 4096, NLORA = 1536, KLORA = 256;
constexpr int ZR0 = 768;
constexpr float RMS_EPS = 1e-6f, GN_EPS = 64e-5f;
constexpr size_t MiB = 1u << 20;
constexpr size_t WS_WIN = 2 * MiB, WS_WOUT = 8 * MiB, WS_WUP = 10 * MiB, WS_WDOWN = 18 * MiB, WS_BL = 26 * MiB;
constexpr size_t WS_MIX = 32 * MiB, WS_XN = 160 * MiB, WS_Z = 288 * MiB, WS_ALORA = 608 * MiB, WS_LORA = 640 * MiB, WS_H = 288 * MiB, WS_PB = 832 * MiB, WS_QB = 896 * MiB, WS_END = 960 * MiB;
constexpr int LDS_BYTES = 147456;

#define GAS __attribute__((address_space(1)))
#define LAS __attribute__((address_space(3)))
typedef unsigned short bf16;
typedef unsigned v4u __attribute__((ext_vector_type(4)));
typedef unsigned v2u __attribute__((ext_vector_type(2)));
typedef float f32x4 __attribute__((ext_vector_type(4)));
typedef float f32x2 __attribute__((ext_vector_type(2)));
typedef float f32x16 __attribute__((ext_vector_type(16)));
typedef short bf16x8 __attribute__((ext_vector_type(8)));
typedef short s16x4 __attribute__((ext_vector_type(4)));
#define LDS_WAIT() asm volatile("s_waitcnt lgkmcnt(0)" ::: "memory")
#define VM_WAIT() asm volatile("s_waitcnt vmcnt(0)" ::: "memory")
typedef __bf16 bf16x2_t __attribute__((ext_vector_type(2)));
__device__ __forceinline__ unsigned f2bf(float f) { return (unsigned)__builtin_bit_cast(unsigned short, (__bf16)f); }
__device__ __forceinline__ unsigned pk2(float lo, float hi) { const bf16x2_t v = __builtin_convertvector((f32x2){lo, hi}, bf16x2_t); return __builtin_bit_cast(unsigned, v); }
__device__ __forceinline__ float bf2f(unsigned short b) { return __builtin_bit_cast(float, (unsigned)b << 16); }
__device__ __forceinline__ float bflo(unsigned w) { return __builtin_bit_cast(float, w << 16); }
__device__ __forceinline__ float bfhi(unsigned w) { return __builtin_bit_cast(float, w & 0xffff0000u); }
__device__ __forceinline__ float wave_sum(float v) {
#pragma unroll
    for (int o = 1; o < 64; o <<= 1) v += __shfl_xor(v, o);
    return v;
}
template <int CTRL, int RM = 0xF> __device__ __forceinline__ float dppf(float v) { return __builtin_bit_cast(float, __builtin_amdgcn_update_dpp(0, __builtin_bit_cast(int, v), CTRL, RM, 0xF, true)); }
__device__ __forceinline__ float red16(float v) { v += dppf<0xB1>(v); v += dppf<0x4E>(v); v += dppf<0x141>(v); v += dppf<0x140>(v); return v; }
__device__ __forceinline__ float red4(float v) { v += dppf<0xB1>(v); v += dppf<0x4E>(v); return v; }
__device__ __forceinline__ float red8(float v) { v += dppf<0xB1>(v); v += dppf<0x4E>(v); v += dppf<0x141>(v); return v; }
__device__ __forceinline__ float wsum(float v) {
    v += dppf<0xB1>(v); v += dppf<0x4E>(v); v += dppf<0x141>(v); v += dppf<0x140>(v);
    v += dppf<0x142, 0xA>(v); v += dppf<0x143, 0xC>(v);
    return __builtin_bit_cast(float, __builtin_amdgcn_readlane(__builtin_bit_cast(int, v), 63));
}
__device__ __forceinline__ float sigmoidf_(float x) { return __builtin_amdgcn_rcpf(1.0f + __expf(-x)); }
#define WG_BAR_LDS() do { asm volatile("s_waitcnt lgkmcnt(0)" ::: "memory"); __builtin_amdgcn_s_barrier(); asm volatile("" ::: "memory"); } while (0)
__device__ __forceinline__ void wg_global_sync() { VM_WAIT(); __syncthreads(); __builtin_amdgcn_fence(__ATOMIC_ACQUIRE, "agent"); VM_WAIT(); }

struct Args { const float* in[20]; float* out; unsigned char* ws; };
__device__ __forceinline__ void team_barrier(unsigned* cnt, unsigned np) {
    VM_WAIT(); __syncthreads();
    if (threadIdx.x == 0) {
        __builtin_amdgcn_fence(__ATOMIC_RELEASE, "agent"); VM_WAIT();
        __hip_atomic_fetch_add(cnt, 1u, __ATOMIC_RELAXED, __HIP_MEMORY_SCOPE_AGENT);
        unsigned sp = 0;
        while (__hip_atomic_load(cnt, __ATOMIC_RELAXED, __HIP_MEMORY_SCOPE_AGENT) < np) { __builtin_amdgcn_s_sleep(2); if (++sp > (1u << 22)) break; }
        __builtin_amdgcn_fence(__ATOMIC_ACQUIRE, "agent"); VM_WAIT();
    }
    __syncthreads();
}
__device__ __forceinline__ void p0_transpose_item(const float* W, int K, int N, bf16* WT, LAS float* scr, int item, int lane) {
    const int nblk = N / 32, kb = item / nblk, nb = item % nblk, k0 = 64 * kb, n0 = 32 * nb;
#pragma unroll 8
    for (int i = 0; i < 32; ++i) { const int kk = 2 * i + (lane >> 5); scr[kk * 33 + (lane & 31)] = W[(size_t)(k0 + kk) * N + n0 + (lane & 31)]; }
    LDS_WAIT(); asm volatile("" ::: "memory");
    const int c = lane & 7;
#pragma unroll
    for (int j = 0; j < 4; ++j) { const int n = (lane >> 3) + 8 * j; const LAS float* s = scr + (8 * c) * 33 + n;
        v4u o; o.x = pk2(s[0 * 33], s[1 * 33]); o.y = pk2(s[2 * 33], s[3 * 33]); o.z = pk2(s[4 * 33], s[5 * 33]); o.w = pk2(s[6 * 33], s[7 * 33]);
        *(GAS v4u*)(WT + (size_t)(n0 + n) * K + k0 + 8 * c) = o; }
    LDS_WAIT(); asm volatile("" ::: "memory");
}
template <int NR> __device__ __forceinline__ void rms_rows_to_bf16(const float* x0, size_t xstride, const float* g, bf16* o0, size_t ostride, int lane) {
    const GAS f32x4* gr = (const GAS f32x4*)g + lane;
    f32x4 v[NR][4]; float s[NR];
#pragma unroll
    for (int r = 0; r < NR; ++r) { const GAS f32x4* xr = (const GAS f32x4*)(x0 + r * xstride) + lane;
#pragma unroll
        for (int j = 0; j < 4; ++j) v[r][j] = xr[64 * j]; }
#pragma unroll
    for (int r = 0; r < NR; ++r) { float a = 0.f;
#pragma unroll
        for (int j = 0; j < 4; ++j) a += (v[r][j].x * v[r][j].x + v[r][j].y * v[r][j].y) + (v[r][j].z * v[r][j].z + v[r][j].w * v[r][j].w);
        s[r] = a; }
#pragma unroll
    for (int r = 0; r < NR; ++r) { const float rstd = __builtin_amdgcn_rsqf(wsum(s[r]) * (1.f / D) + RMS_EPS);
        GAS unsigned long long* o8 = (GAS unsigned long long*)(o0 + r * ostride) + lane;
#pragma unroll
        for (int j = 0; j < 4; ++j) { const f32x4 gg = gr[64 * j]; o8[64 * j] = (unsigned long long)pk2(v[r][j].x * rstd * gg.x, v[r][j].y * rstd * gg.y) | ((unsigned long long)pk2(v[r][j].z * rstd * gg.z, v[r][j].w * rstd * gg.w) << 32); } }
}
template <int NR> __device__ __forceinline__ void rms_rows_inplace(float* x0, size_t xstride, const float* g, int lane) {
    const GAS f32x4* gr = (const GAS f32x4*)g + lane;
    f32x4 v[NR][4]; float s[NR];
#pragma unroll
    for (int r = 0; r < NR; ++r) { const GAS f32x4* xr = (const GAS f32x4*)(x0 + r * xstride) + lane;
#pragma unroll
        for (int j = 0; j < 4; ++j) v[r][j] = xr[64 * j]; }
#pragma unroll
    for (int r = 0; r < NR; ++r) { float a = 0.f;
#pragma unroll
        for (int j = 0; j < 4; ++j) a += (v[r][j].x * v[r][j].x + v[r][j].y * v[r][j].y) + (v[r][j].z * v[r][j].z + v[r][j].w * v[r][j].w);
        s[r] = a; }
#pragma unroll
    for (int r = 0; r < NR; ++r) { const float rstd = __builtin_amdgcn_rsqf(wsum(s[r]) * (1.f / D) + RMS_EPS);
        GAS f32x4* xr = (GAS f32x4*)(x0 + r * xstride) + lane;
#pragma unroll
        for (int j = 0; j < 4; ++j) { const f32x4 gg = gr[64 * j]; xr[64 * j] = v[r][j] * rstd * gg; } }
}

__device__ __forceinline__ void lora_in_row(const bf16* Z, const float* mu, bf16* AL, int m, int lane) {
    const int c = 4 * lane;
    const v2u zc = *(const GAS v2u*)(Z + (size_t)m * INW + 2304 + c);
    const bool hasp = (m % T) != 0;
    const v2u zp = *(const GAS v2u*)(Z + (size_t)(hasp ? m - 1 : m) * INW + 2304 + c);
    const float fac = hasp ? 1.f : 0.f;
    const f32x4 mv = *(const GAS f32x4*)(mu + 1536 + c);
    float z[4] = {bflo(zc.x), bfhi(zc.x), bflo(zc.y), bfhi(zc.y)}, p[4] = {bflo(zp.x) * fac, bfhi(zp.x) * fac, bflo(zp.y) * fac, bfhi(zp.y) * fac}, o[4];
#pragma unroll
    for (int j = 0; j < 4; ++j) { const float v = z[j] + (p[j] - z[j]) * mv[j];
        o[j] = (c < 64) ? (1.f - 2.f / (1.f + __expf(2.f * v))) : ((c < 128) ? v : sigmoidf_(v)); }
    v2u w; w.x = pk2(o[0], o[1]); w.y = pk2(o[2], o[3]);
    *(GAS v2u*)(AL + (size_t)m * KLORA + c) = w;
}

constexpr int AT_KSTR = 144, AT_VSTR = 520, AT_VOFF = 256 * AT_KSTR;
__device__ __forceinline__ int crow(int r, int hi) { return (r & 3) + 8 * (r >> 2) + 4 * hi; }
__device__ __forceinline__ void attn_unit(LAS unsigned char* lds, const bf16* Z, bf16* MIX, const float* sinks, int b, int nb, int kvh) {
    const int tid = threadIdx.x, wid = __builtin_amdgcn_readfirstlane(tid >> 6), lane = tid & 63;
    __syncthreads();
#pragma unroll
    for (int i = 0; i < 4; ++i) {
        const int chunk = tid + 512 * i, key = chunk >> 3, c8 = chunk & 7, kpos = nb * 128 - 128 + key;
        v4u kv = (v4u){0u, 0u, 0u, 0u}, vv = (v4u){0u, 0u, 0u, 0u};
        if (kpos >= 0) { const bf16* zr = Z + (size_t)(b * T + kpos) * INW + 512 + kvh * 64 + c8 * 8; kv = *(const GAS v4u*)zr; vv = *(const GAS v4u*)(zr + 128); }
        *(LAS v4u*)(lds + key * AT_KSTR + c8 * 16) = kv;
        LAS unsigned short* vt = (LAS unsigned short*)(lds + AT_VOFF + (c8 * 8) * AT_VSTR + key * 2);
#pragma unroll
        for (int e = 0; e < 4; ++e) { vt[(2 * e) * (AT_VSTR / 2)] = (unsigned short)(vv[e] & 0xffffu); vt[(2 * e + 1) * (AT_VSTR / 2)] = (unsigned short)(vv[e] >> 16); }
    }
    __syncthreads();
    const int g = wid >> 1, hq = kvh * 4 + g, qhalf = wid & 1, q = lane & 31, hh = lane >> 5;
    const float slope = exp2f(-(float)(hq + 1)), sink = sinks[hq];
    for (int qt = 0; qt < 2; ++qt) {
        const int q0 = qhalf * 64 + qt * 32, qi = q0 + q, kt0 = q0 >> 5; const size_t m = (size_t)b * T + nb * 128 + qi;
        bf16x8 qf[4];
#pragma unroll
        for (int s = 0; s < 4; ++s) qf[s] = *(const GAS bf16x8*)(Z + m * INW + hq * 64 + 16 * s + 8 * hh);
        f32x16 sc[5];
#pragma unroll
        for (int i = 0; i < 5; ++i) {
#pragma unroll
            for (int r = 0; r < 16; ++r) sc[i][r] = 0.f;
#pragma unroll
            for (int s = 0; s < 4; ++s) { const bf16x8 a = *(const LAS bf16x8*)(lds + (32 * (kt0 + i) + q) * AT_KSTR + (16 * s + 8 * hh) * 2); sc[i] = __builtin_amdgcn_mfma_f32_32x32x16_bf16(a, qf[s], sc[i], 0, 0, 0); }
        }
        float mx = -1e30f;
#pragma unroll
        for (int i = 0; i < 5; ++i)
#pragma unroll
            for (int r = 0; r < 16; ++r) { const int kj = 32 * (kt0 + i) + crow(r, hh), dist = qi - kj + 128; const bool valid = (dist >= 0) && (dist < 128) && (nb * 128 - 128 + kj >= 0);
                const float v = valid ? (sc[i][r] * 0.125f - slope * (float)dist) : -1e30f; sc[i][r] = v; mx = fmaxf(mx, v); }
        mx = fmaxf(mx, __shfl_xor(mx, 32)); mx = fmaxf(mx, sink);
        float sum = 0.f;
#pragma unroll
        for (int i = 0; i < 5; ++i)
#pragma unroll
            for (int r = 0; r < 16; ++r) { const float e = __expf(sc[i][r] - mx); sc[i][r] = e; sum += e; }
        sum += __shfl_xor(sum, 32);
        const float inv = 1.0f / (sum + __expf(sink - mx));
        f32x16 o[2];
#pragma unroll
        for (int r = 0; r < 16; ++r) { o[0][r] = 0.f; o[1][r] = 0.f; }
#pragma unroll
        for (int i = 0; i < 5; ++i)
#pragma unroll
            for (int s = 0; s < 2; ++s) {
                v4u pw;
#pragma unroll
                for (int j = 0; j < 4; ++j) pw[j] = pk2(sc[i][8 * s + 2 * j] * inv, sc[i][8 * s + 2 * j + 1] * inv);
                const bf16x8 xs = __builtin_bit_cast(bf16x8, pw);
                const int kb = 32 * (kt0 + i) + 16 * s + 4 * hh;
#pragma unroll
                for (int dt = 0; dt < 2; ++dt) { const LAS unsigned char* vp = lds + AT_VOFF + (dt * 32 + q) * AT_VSTR + kb * 2;
                    const s16x4 lo = *(const LAS s16x4*)vp, hi = *(const LAS s16x4*)(vp + 16);
                    const bf16x8 pa = __builtin_shufflevector(lo, hi, 0, 1, 2, 3, 4, 5, 6, 7);
                    o[dt] = __builtin_amdgcn_mfma_f32_32x32x16_bf16(pa, xs, o[dt], 0, 0, 0); }
            }
        bf16* orow = MIX + m * D + hq * 64 + 4 * hh;
#pragma unroll
        for (int dt = 0; dt < 2; ++dt)
#pragma unroll
            for (int r4 = 0; r4 < 4; ++r4) { v2u w; w.x = pk2(o[dt][4 * r4], o[dt][4 * r4 + 1]); w.y = pk2(o[dt][4 * r4 + 2], o[dt][4 * r4 + 3]); *(GAS v2u*)(orow + dt * 32 + 8 * r4) = w; }
    }
}

constexpr int TC = 16, NCH = T / TC;
constexpr int SC_W = 0, SC_A = TC * 64, SC_B = 2 * TC * 64, SC_K = 3 * TC * 64, SC_R = 4 * TC * 64, SC_V = 5 * TC * 64, SC_G = 6 * TC * 64, SC_BON = 7 * TC * 64, SC_YP = 7 * TC * 64 + 64, SC_BUF = SC_YP + TC * 32 * 4;
static_assert(2 * SC_BUF * 4 <= 131072, "scan LDS");
struct ScanConst { f32x4 mu_r, mu_k, mu_v, w0, a0, kk, ka, rk; };
struct ScanRaw { v2u zr[3], zp[3], lo[3]; float fac; };
__device__ __forceinline__ f32x4 unpack4(v2u p) { return (f32x4){bflo(p.x), bfhi(p.x), bflo(p.y), bfhi(p.y)}; }
__device__ __forceinline__ float sum4(f32x4 v) { return (v.x + v.y) + (v.z + v.w); }
__device__ __forceinline__ void scan_load(ScanRaw& R, const bf16* Z, const bf16* LORA, int b, int h, int t0, int k4, int lane) {
    const int t = 4 * k4 + (lane >> 4), hc = h * 64 + 4 * (lane & 15); const size_t m = (size_t)b * T + t0 + t; const bool hasp = (t0 + t) > 0; R.fac = hasp ? 1.f : 0.f;
    const bf16* zrow = Z + m * INW + ZR0 + hc; const bf16* prow = hasp ? zrow - INW : zrow; const bf16* lrow = LORA + m * NLORA + hc;
#pragma unroll
    for (int j = 0; j < 3; ++j) { R.zr[j] = *(const GAS v2u*)(zrow + 512 * j); R.zp[j] = *(const GAS v2u*)(prow + 512 * j); R.lo[j] = *(const GAS v2u*)(lrow + 512 * j); }
}
__device__ __forceinline__ void scan_store(LAS float* buf, const ScanRaw& R, int k4, int lane, const ScanConst& c) {
    const int t = 4 * k4 + (lane >> 4), cg = lane & 15;
    const f32x4 zr = unpack4(R.zr[0]), zk = unpack4(R.zr[1]), zv = unpack4(R.zr[2]);
    const f32x4 xr = zr + (unpack4(R.zp[0]) * R.fac - zr) * c.mu_r, xk = zk + (unpack4(R.zp[1]) * R.fac - zk) * c.mu_k, xv = zv + (unpack4(R.zp[2]) * R.fac - zv) * c.mu_v;
    const f32x4 lw = unpack4(R.lo[0]) + c.w0, la = unpack4(R.lo[1]) + c.a0, g = unpack4(R.lo[2]);
    f32x4 w, a;
#pragma unroll
    for (int e = 0; e < 4; ++e) { w[e] = __expf(-0.60653066f * sigmoidf_(lw[e])); a[e] = sigmoidf_(la[e]); }
    const f32x4 kkr = xk * c.kk; const float ss = red16(sum4(kkr * kkr)); const f32x4 kk = kkr * __builtin_amdgcn_rsqf(fmaxf(ss, 1e-24f));
    const f32x4 k = xk * (1.f + (a - 1.f) * c.ka);
    const float bon = red16(sum4(xr * k * c.rk));
    *(LAS f32x4*)(buf + SC_W + t * 64 + 4 * cg) = w; *(LAS f32x4*)(buf + SC_A + t * 64 + 4 * cg) = -kk; *(LAS f32x4*)(buf + SC_B + t * 64 + 4 * cg) = kk * a; *(LAS f32x4*)(buf + SC_K + t * 64 + 4 * cg) = k;
    *(LAS f32x4*)(buf + SC_R + t * 64 + 4 * cg) = xr; *(LAS f32x4*)(buf + SC_V + t * 64 + 4 * cg) = xv; *(LAS f32x4*)(buf + SC_G + t * 64 + 4 * cg) = g; if (cg == 0) buf[SC_BON + t] = bon;
}
__device__ __forceinline__ void scan_output(const LAS float* buf, float* Y, bf16* PB, bf16* QB, int b, int h, int half, int t0, int k4, int lane, f32x2 lnw2, f32x2 lnb2) {
    const int t = 4 * k4 + (lane >> 4), cg = lane & 15, row = half * 32 + 2 * cg; const size_t m = (size_t)b * T + t0 + t;
    const LAS f32x4* yp = (const LAS f32x4*)(buf + SC_YP + (t * 32 + 2 * cg) * 4);
    f32x2 y; y.x = sum4(yp[0]); y.y = sum4(yp[1]);
    const f32x2 v = *(const LAS f32x2*)(buf + SC_V + t * 64 + row), g = *(const LAS f32x2*)(buf + SC_G + t * 64 + row);
    const float bon = buf[SC_BON + t];
    const f32x2 P = g * lnw2, Q = (lnb2 + v * bon) * g;
    const size_t off = m * 512 + h * 64 + row;
    *(GAS f32x2*)(Y + off) = y; *(GAS unsigned*)(PB + off) = pk2(P.x, P.y); *(GAS unsigned*)(QB + off) = pk2(Q.x, Q.y);
}
struct ScanOps { f32x4 a, w, b, k, r; float v0, v1; };
__device__ __forceinline__ void scan_ops_load(ScanOps& o, const LAS float* buf, int t, int slice, int vrow) {
    o.a = *(const LAS f32x4*)(buf + SC_A + t * 64 + slice * 4); o.w = *(const LAS f32x4*)(buf + SC_W + t * 64 + slice * 4); o.b = *(const LAS f32x4*)(buf + SC_B + t * 64 + slice * 4);
    o.k = *(const LAS f32x4*)(buf + SC_K + t * 64 + slice * 4); o.r = *(const LAS f32x4*)(buf + SC_R + t * 64 + slice * 4);
    o.v0 = buf[SC_V + t * 64 + vrow]; o.v1 = buf[SC_V + t * 64 + vrow + 16];
}
__device__ __forceinline__ void scan_steps(LAS float* buf, f32x2 (&S0)[2], f32x2 (&S1)[2], int slice, int rq, int vrow) {
    ScanOps cur; scan_ops_load(cur, buf, 0, slice, vrow);
    float yp0 = 0.f, yp1 = 0.f;
#pragma unroll
    for (int t = 0; t < TC; ++t) {
        ScanOps nxt; if (t + 1 < TC) scan_ops_load(nxt, buf, t + 1, slice, vrow);
        __builtin_amdgcn_sched_barrier(0);
        const f32x2 a[2] = {cur.a.xy, cur.a.zw}, w[2] = {cur.w.xy, cur.w.zw}, bb[2] = {cur.b.xy, cur.b.zw}, k[2] = {cur.k.xy, cur.k.zw}, r[2] = {cur.r.xy, cur.r.zw};
        const f32x2 d0 = S0[0] * a[0] + S0[1] * a[1], d1 = S1[0] * a[0] + S1[1] * a[1];
        float e0 = d0.x + d0.y, e1 = d1.x + d1.y;
        e0 += dppf<0xB1>(e0); e1 += dppf<0xB1>(e1); yp0 += dppf<0xB1>(yp0); yp1 += dppf<0xB1>(yp1);
        e0 += dppf<0x4E>(e0); e1 += dppf<0x4E>(e1); yp0 += dppf<0x4E>(yp0); yp1 += dppf<0x4E>(yp1);
        e0 += dppf<0x141>(e0); e1 += dppf<0x141>(e1);
        if (t > 0) { buf[SC_YP + ((t - 1) * 32 + rq) * 4 + (slice >> 2)] = yp0; buf[SC_YP + ((t - 1) * 32 + rq + 16) * 4 + (slice >> 2)] = yp1; }
        e0 += dppf<0x140>(e0); e1 += dppf<0x140>(e1);
        const f32x2 sa0v = {e0, e0}, sa1v = {e1, e1}, v0v = {cur.v0, cur.v0}, v1v = {cur.v1, cur.v1};
#pragma unroll
        for (int q = 0; q < 2; ++q) { S0[q] = S0[q] * w[q] + (sa0v * bb[q] + v0v * k[q]); S1[q] = S1[q] * w[q] + (sa1v * bb[q] + v1v * k[q]); }
        const f32x2 y0 = S0[0] * r[0] + S0[1] * r[1], y1 = S1[0] * r[0] + S1[1] * r[1];
        yp0 = y0.x + y0.y; yp1 = y1.x + y1.y;
        __builtin_amdgcn_sched_barrier(0);
        if (t + 1 < TC) cur = nxt;
    }
    yp0 = red4(yp0); yp1 = red4(yp1);
    buf[SC_YP + ((TC - 1) * 32 + rq) * 4 + (slice >> 2)] = yp0; buf[SC_YP + ((TC - 1) * 32 + rq + 16) * 4 + (slice >> 2)] = yp1;
}
__device__ __forceinline__ void scan_unit(LAS float* lds, const bf16* Z, const bf16* LORA, float* Y, bf16* PB, bf16* QB, const Args& args, int b, int h, int half) {
    const int tid = threadIdx.x, wid = __builtin_amdgcn_readfirstlane(tid >> 6), lane = tid & 63;
    __syncthreads();
    if (wid < 4) {
        const int slice = tid & 15, rq = tid >> 4, vrow = half * 32 + rq;
        f32x2 S0[2], S1[2];
#pragma unroll
        for (int q = 0; q < 2; ++q) { S0[q] = (f32x2){0.f, 0.f}; S1[q] = (f32x2){0.f, 0.f}; }
        WG_BAR_LDS();
        for (int ch = 0; ch < NCH; ++ch) { scan_steps(lds + (ch & 1) * SC_BUF, S0, S1, slice, rq, vrow); WG_BAR_LDS(); }
    } else {
        const int k4 = wid - 4, hc4 = h * 64 + 4 * (lane & 15), row = h * 64 + half * 32 + 2 * (lane & 15);
        ScanConst c; c.mu_r = *(const GAS f32x4*)(args.in[4] + hc4); c.mu_k = *(const GAS f32x4*)(args.in[4] + 512 + hc4); c.mu_v = *(const GAS f32x4*)(args.in[4] + 1024 + hc4); c.w0 = *(const GAS f32x4*)(args.in[5] + hc4); c.a0 = *(const GAS f32x4*)(args.in[7] + hc4);
        c.kk = *(const GAS f32x4*)(args.in[10] + hc4); c.ka = *(const GAS f32x4*)(args.in[11] + hc4); c.rk = *(const GAS f32x4*)(args.in[12] + hc4);
        const f32x2 lnw2 = *(const GAS f32x2*)(args.in[13] + row), lnb2 = *(const GAS f32x2*)(args.in[14] + row);
        ScanRaw Re, Ro; scan_load(Re, Z, LORA, b, h, 0, k4, lane); scan_store(lds, Re, k4, lane, c); scan_load(Ro, Z, LORA, b, h, TC, k4, lane); scan_load(Re, Z, LORA, b, h, 2 * TC, k4, lane);
        WG_BAR_LDS();
        for (int ch = 0; ch < NCH; ch += 2) {
            {
                LAS float* oth = lds + SC_BUF;
                if (ch > 0) scan_output(oth, Y, PB, QB, b, h, half, (ch - 1) * TC, k4, lane, lnw2, lnb2);
                scan_store(oth, Ro, k4, lane, c);
                if (ch + 3 < NCH) scan_load(Ro, Z, LORA, b, h, (ch + 3) * TC, k4, lane);
                WG_BAR_LDS();
            }
            {
                LAS float* oth = lds;
                scan_output(oth, Y, PB, QB, b, h, half, ch * TC, k4, lane, lnw2, lnb2);
                if (ch + 2 < NCH) { scan_store(oth, Re, k4, lane, c); if (ch + 4 < NCH) scan_load(Re, Z, LORA, b, h, (ch + 4) * TC, k4, lane); }
                WG_BAR_LDS();
            }
        }
        scan_output(lds + ((NCH - 1) & 1) * SC_BUF, Y, PB, QB, b, h, half, (NCH - 1) * TC, k4, lane, lnw2, lnb2);
    }
    __syncthreads();
}
__device__ __forceinline__ void rwkv_post_panel(const float* Y, const bf16* PB, const bf16* QB, bf16* MIX, int pm, int wave, int lane) {
    const int tsub = lane >> 4, cg = lane & 15;
    for (int j0 = 0; j0 < 64; j0 += 4) {
        f32x4 y[4]; v2u p[4], q[4];
#pragma unroll
        for (int u = 0; u < 4; ++u) { const size_t off = (size_t)(pm * 256 + (j0 + u) * 4 + tsub) * 512 + wave * 64 + 4 * cg; y[u] = *(const GAS f32x4*)(Y + off); p[u] = *(const GAS v2u*)(PB + off); q[u] = *(const GAS v2u*)(QB + off); }
#pragma unroll
        for (int u = 0; u < 4; ++u) { const size_t m = (size_t)(pm * 256 + (j0 + u) * 4 + tsub);
            const float mean = red16(sum4(y[u])) * (1.f / 64.f); const f32x4 d = y[u] - mean; const float var = red16(sum4(d * d)) * (1.f / 64.f);
            const f32x4 o = d * __builtin_amdgcn_rsqf(var + GN_EPS) * unpack4(p[u]) + unpack4(q[u]);
            v2u pw; pw.x = pk2(o[0], o[1]); pw.y = pk2(o[2], o[3]);
            *(GAS v2u*)(MIX + m * D + 512 + wave * 64 + 4 * cg) = pw; }
    }
}

__global__ void __launch_bounds__(NWAVES * 64, 2) mk_fwd(Args args) {
    extern __shared__ __attribute__((aligned(16))) unsigned char lds_raw[];
    LAS unsigned char* lds = (LAS unsigned char*)lds_raw;
    cg::grid_group grid = cg::this_grid();
    const int tid = threadIdx.x, lane = tid & 63, wave = __builtin_amdgcn_readfirstlane(tid >> 6);
    const int G = gridDim.x, bx = blockIdx.x;
    unsigned char* ws = args.ws;
    const float* x = args.in[0]; float* out = args.out;
    bf16* WIN = (bf16*)(ws + WS_WIN); bf16* WOUT = (bf16*)(ws + WS_WOUT); bf16* WUP = (bf16*)(ws + WS_WUP); bf16* WDOWN = (bf16*)(ws + WS_WDOWN); bf16* BL = (bf16*)(ws + WS_BL);
    bf16* MIX = (bf16*)(ws + WS_MIX); float* Yb = (float*)(ws + WS_XN); bf16* PB = (bf16*)(ws + WS_PB); bf16* QB = (bf16*)(ws + WS_QB); bf16* XN = (bf16*)(ws + WS_XN); bf16* Zb = (bf16*)(ws + WS_Z); bf16* AL = (bf16*)(ws + WS_ALORA); bf16* LORA = (bf16*)(ws + WS_LORA); bf16* HB = (bf16*)(ws + WS_H);

    {
        LAS float* scr = (LAS float*)(lds + wave * 16384);
        const int gw = bx * NWAVES + wave, NGW = G * NWAVES;
        constexpr int I_IN = (D / 64) * (INW / 32), I_OUT = (D / 64) * (D / 32), I_UP = (D / 64) * (FF / 32), I_DN = (FF / 64) * (D / 32);
        constexpr int NITEMS = I_IN + I_OUT + I_UP + I_DN;
        for (int it = gw; it < NITEMS; it += NGW) {
            int r = it;
            if (r < I_IN) { p0_transpose_item(args.in[2], D, INW, WIN, scr, r, lane); continue; } r -= I_IN;
            if (r < I_OUT) { p0_transpose_item(args.in[15], D, D, WOUT, scr, r, lane); continue; } r -= I_OUT;
            if (r < I_UP) { p0_transpose_item(args.in[17], D, FF, WUP, scr, r, lane); continue; } r -= I_UP;
            p0_transpose_item(args.in[18], FF, D, WDOWN, scr, r, lane);
        }
        if (bx == 0) for (int i = tid; i < 16384; i += NWAVES * 64) ((unsigned*)ws)[i] = 0u;
        for (int idx = bx * (NWAVES * 64) + tid; idx < NLORA * KLORA; idx += G * NWAVES * 64) {
            const int n = idx / KLORA, k = idx % KLORA; float v = 0.f;
            if (n < 512) { if (k < 64) v = args.in[6][k * 512 + n]; }
            else if (n < 1024) { if (k >= 64 && k < 128) v = args.in[8][(k - 64) * 512 + (n - 512)]; }
            else { if (k >= 128) v = args.in[9][(k - 128) * 512 + (n - 1024)]; }
            BL[idx] = (bf16)f2bf(v);
        }
        for (int m = gw * 4; m < M; m += NGW * 4) rms_rows_to_bf16<4>(x + (size_t)m * D, D, args.in[1], XN + (size_t)m * D, D, lane);
    }
    grid.sync();
    for (int rep_ = 0; rep_ < REP_P1; ++rep_) {
        pg8::Gemm g{XN, WIN, M, INW, D}; pg8::StaticOrder S; S.init(M, INW, G, bx);
        pg8::EpiBf16<0> E{Zb, INW, nullptr, 0, 0, 1.f};
#ifndef NO_P1
        pg8::gemm_phase<pg8::EpiBf16<0>, pg8::StaticOrder, PG8_ALIGN, PG8_SP2>(lds, g, S, E);
#endif
    }
    grid.sync();
    if (bx < M / 256) { const int pm = bx;
        for (int r = wave * 4; r < 256; r += NWAVES * 4) {
#pragma unroll
            for (int q = 0; q < 4; ++q) lora_in_row(Zb, args.in[4], AL, pm * 256 + r + q, lane); }
        wg_global_sync();
        pg8::Gemm g{AL, BL, M, NLORA, KLORA}; pg8::PanelOrder S{pm, NLORA / 256};
        pg8::EpiBf16<0> E{LORA, NLORA, nullptr, 0, 0, 1.f};
#ifndef NO_P1B
        pg8::gemm_phase<pg8::EpiBf16<0>, pg8::PanelOrder, PG8_ALIGN, PG8_SP2>(lds, g, S, E);
#endif
    }
    grid.sync();
    {
        for (int u = bx; u < BATCH * 32 * 2; u += G) attn_unit(lds, Zb, MIX, args.in[3], u >> 6, (u >> 1) & 31, u & 1);
        for (int u = bx; u < BATCH * 16; u += G) scan_unit((LAS float*)lds, Zb, LORA, Yb, PB, QB, args, u >> 4, (u >> 1) & 7, u & 1);
    }
    grid.sync();
    for (int rep_ = 0; rep_ < REP_CHAIN; ++rep_) if (bx < M / 256) { const int pm = bx;
        rwkv_post_panel(Yb, PB, QB, MIX, pm, wave, lane);
        wg_global_sync();
        { pg8::Gemm g{MIX, WOUT, M, D, D}; pg8::PanelOrder S{pm, D / 256}; pg8::EpiResF32 E{x, out, D};

#ifndef NO_P35
          pg8::gemm_phase<pg8::EpiResF32, pg8::PanelOrder, PG8_ALIGN, PG8_SP2>(lds, g, S, E);
#endif
 }
        wg_global_sync();
        for (int r = wave * 4; r < 256; r += NWAVES * 4) rms_rows_to_bf16<4>(out + (size_t)(pm * 256 + r) * D, D, args.in[16], XN + (size_t)(pm * 256 + r) * D, D, lane);
        wg_global_sync();
        for (int r4_ = 0; r4_ < REP_P4; ++r4_)
        { pg8::Gemm g{XN, WUP, M, FF, D}; pg8::PanelOrder S{pm, FF / 256}; pg8::EpiBf16<2> E{HB, FF, nullptr, 0, 0, 1.f};

#ifndef NO_P4
          pg8::gemm_phase<pg8::EpiBf16<2>, pg8::PanelOrder, PG8_ALIGN, PG8_SP2>(lds, g, S, E);
#endif
 }
        wg_global_sync();
        { const int xq = bx & 7, role = (bx >> 3) & 3, q = bx >> 5; unsigned* tcnt = (unsigned*)ws + (size_t)(q * 8 + xq) * 128;
          team_barrier(tcnt, 4u);
          pg8::Gemm g{HB, WDOWN, M, D, FF}; pg8::TeamOrder S{q * 32 + xq, 8, role, 4, 1}; pg8::EpiResF32 E{out, out, D};
          pg8::gemm_phase<pg8::EpiResF32, pg8::TeamOrder, PG8_ALIGN, PG8_SP2>(lds, g, S, E);
          team_barrier(tcnt + 64, 4u); }
        for (int r = wave * 4; r < 256; r += NWAVES * 4) rms_rows_inplace<4>(out + (size_t)(pm * 256 + r) * D, D, args.in[19], lane);
    }
}

extern "C" void kernel_launch(void* const* d_in, const int* in_sizes, int n_in, void* d_out, int out_size, void* d_ws, size_t ws_size, hipStream_t stream) {
    static int grid = 0;
    if (grid == 0) {
        if (n_in != 20 || in_sizes[0] != M * D || out_size != M * D || ws_size < WS_END) { fprintf(stderr, "kernel_launch: unexpected shapes (n_in %d, in0 %d, out %d, ws %zu)\n", n_in, n_in > 0 ? in_sizes[0] : -1, out_size, ws_size); grid = -1; return; }
        int dev = 0, cus = 0, per_cu = 0;
        if (hipGetDevice(&dev) != hipSuccess || hipDeviceGetAttribute(&cus, hipDeviceAttributeMultiprocessorCount, dev) != hipSuccess) { grid = -1; return; }
        if (hipFuncSetAttribute((const void*)mk_fwd, hipFuncAttributeMaxDynamicSharedMemorySize, LDS_BYTES) != hipSuccess) { fprintf(stderr, "kernel_launch: hipFuncSetAttribute failed\n"); grid = -1; return; }
        if (hipOccupancyMaxActiveBlocksPerMultiprocessor(&per_cu, (const void*)mk_fwd, NWAVES * 64, LDS_BYTES) != hipSuccess || per_cu < 1) { fprintf(stderr, "kernel_launch: occupancy query says %d\n", per_cu); (void)hipGetLastError(); per_cu = 1; }
        if (cus < M / 256) { fprintf(stderr, "kernel_launch: needs >= 256 CUs\n"); grid = -1; return; }
        grid = M / 256;
    }
    if (grid < 0) return;
    Args a{};
    for (int i = 0; i < 20; ++i) a.in[i] = (const float*)d_in[i];
    a.out = (float*)d_out; a.ws = (unsigned char*)d_ws;
    void* kargs[] = {&a};
    hipError_t e = hipLaunchCooperativeKernel((const void*)mk_fwd, dim3(grid), dim3(NWAVES * 64), kargs, LDS_BYTES, stream);
    if (e != hipSuccess) fprintf(stderr, "kernel_launch: cooperative launch failed: %s (grid %d)\n", hipGetErrorString(e), grid);
}
```

```cpp
#include <hip/hip_runtime.h>
#include <hip/hip_cooperative_groups.h>
#include <cstdio>
#include <cstdint>
namespace cg = cooperative_groups;
namespace pg8 {
#define PG8_LAS __attribute__((address_space(3)))
typedef unsigned short bf16_t;
typedef short bf16x8 __attribute__((ext_vector_type(8)));
typedef float f32x4 __attribute__((ext_vector_type(4)));
typedef unsigned u32x4 __attribute__((ext_vector_type(4)));
constexpr int BM = 256, BK = 64, HALF = 128, HTB = HALF * BK * 2  , STAGE_BYTES = 8 * HTB, NXCD = 8, WGM = 8;

__host__ __device__ __forceinline__ int lds_byte(int r, int c) { const int st = (r >> 4) * 2 + (c >> 5), rr = r & 15, cc = c & 31, ob = rr * 64 + cc * 2; return st * 1024 + (ob ^ (((ob >> 9) & 1) << 5)); }
__host__ __device__ __forceinline__ void stage_rc(int b, int& R, int& C) { const int st = b / 1024, sb = b % 1024, swz = sb ^ (((sb >> 9) & 1) << 5); R = (st >> 1) * 16 + swz / 64; C = (st & 1) * 32 + (swz % 64) / 2; }
__host__ __device__ __forceinline__ int perm32(int rho) { const int n = rho >> 4, i = rho & 15; return 8 * (i >> 2) + 4 * n + (i & 3); }

struct Unit { int pm, pn; };
struct Gemm { const bf16_t* A; const bf16_t* Bt; int M, N, K; };

struct StaticOrder {
    int nM, nN, nwg, G, c;
    __host__ __device__ void init(int M, int N, int G_, int c_) { nM = M / BM; nN = N / BM; nwg = nM * nN; G = G_; c = c_; }
    __host__ __device__ bool next(int i, Unit& u) const {
        const long L = (long)i * G + c; if (L >= nwg) return false;
        int wgid = (int)L; { const int q = nwg / NXCD, r = nwg % NXCD, xcd = wgid % NXCD, off = wgid / NXCD; wgid = (xcd < r ? xcd * (q + 1) : r * (q + 1) + (xcd - r) * q) + off; }
        const int nig = WGM * nN, gid = wgid / nig, fm = gid * WGM, gsz = (nM - fm) < WGM ? (nM - fm) : WGM;
        u.pm = fm + ((wgid % nig) % gsz); u.pn = (wgid % nig) / gsz; return true;
    }
    __device__ __forceinline__ void a_ready(const Unit&) const {}
    __device__ __forceinline__ void done(const Unit&) const {}
};

__device__ __forceinline__ unsigned cvt_pk_bf16(float lo, float hi) { unsigned r; asm volatile("v_cvt_pk_bf16_f32 %0, %1, %2" : "=v"(r) : "v"(lo), "v"(hi)); return r; }
template <int ACT  > struct EpiBf16 {
    static constexpr bool PERM = true, AFTER_DRAIN = false; static_assert(ACT == 0 || ACT == 2, "EpiBf16: ACT is 0 (none) or 2 (relu squared)");
    bf16_t* O; int ldc; const float* bias; int split_cols; size_t split_stride; float scale0;
    __device__ __forceinline__ void operator()(const f32x4 (&acc)[2][2][4][2], const Unit& u, int wr, int wc, int fr, int fq) const {
        const int row0 = u.pm * BM + wr * 64 + fr; int colt = u.pn * BM; bf16_t* base = O;
        float sc = 1.f; if (split_cols) { const int t = colt / split_cols; base += (size_t)t * split_stride; colt -= t * split_cols; if (t == 0) sc = scale0; }
        const int col0 = colt + wc * 32 + 8 * fq, bcol0 = u.pn * BM + wc * 32 + 8 * fq;
        f32x4 bv[2][2];
#pragma unroll
        for (int bj = 0; bj < 2; ++bj)
#pragma unroll
            for (int n = 0; n < 2; ++n) bv[bj][n] = bias ? *(const f32x4*)(bias + bcol0 + bj * HALF + 4 * n) : (f32x4){0.f, 0.f, 0.f, 0.f};
#pragma unroll
        for (int ai = 0; ai < 2; ++ai)
#pragma unroll
            for (int m = 0; m < 4; ++m) { bf16_t* rowp = base + (size_t)(row0 + ai * HALF + m * 16) * ldc + col0;
#pragma unroll
                for (int bj = 0; bj < 2; ++bj) { f32x4 v0 = acc[ai][bj][m][0] + bv[bj][0], v1 = acc[ai][bj][m][1] + bv[bj][1];
                    if (ACT == 2) { v0 = __builtin_elementwise_max(v0, (f32x4){0.f, 0.f, 0.f, 0.f}); v1 = __builtin_elementwise_max(v1, (f32x4){0.f, 0.f, 0.f, 0.f}); v0 = v0 * v0; v1 = v1 * v1; }
                    v0 = v0 * sc; v1 = v1 * sc; u32x4 w; w.x = cvt_pk_bf16(v0[0], v0[1]); w.y = cvt_pk_bf16(v0[2], v0[3]); w.z = cvt_pk_bf16(v1[0], v1[1]); w.w = cvt_pk_bf16(v1[2], v1[3]);
                    *(u32x4*)(rowp + bj * HALF) = w; } }
    }
};
struct EpiResF32 {
    static constexpr bool PERM = false, AFTER_DRAIN = false;
    const float* base; float* out; int ldc;
    __device__ __forceinline__ void operator()(const f32x4 (&acc)[2][2][4][2], const Unit& u, int wr, int wc, int fr, int fq) const {
        const int col0 = u.pn * BM + wc * 32 + 4 * fq;
#pragma unroll
        for (int ai = 0; ai < 2; ++ai)
#pragma unroll
            for (int m = 0; m < 4; ++m) { const int r = ai * HALF + wr * 64 + m * 16 + fr; const size_t off = (size_t)(u.pm * BM + r) * ldc + col0;
#pragma unroll
                for (int bj = 0; bj < 2; ++bj)
#pragma unroll
                    for (int n = 0; n < 2; ++n) { const f32x4 bs = *(const f32x4*)(base + off + bj * HALF + n * 16); const f32x4 o = bs + acc[ai][bj][m][n]; *(f32x4*)(out + off + bj * HALF + n * 16) = o; }
                if (m & 1) asm volatile("" ::: "memory"); }
    }
};
struct PanelOrder {
    int pm, nN;
    __device__ __forceinline__ bool next(int i, Unit& u) const { if (i >= nN) return false; u.pm = pm; u.pn = i; return true; }
    __device__ __forceinline__ void a_ready(const Unit&) const {}
    __device__ __forceinline__ void done(const Unit&) const {}
};
struct TeamOrder {
    int pm0, pstride, pn0, np, nt;
    __device__ __forceinline__ bool next(int i, Unit& u) const { if (i >= np * nt) return false; u.pm = pm0 + (i / nt) * pstride; u.pn = pn0 + (i % nt); return true; }
    __device__ __forceinline__ void a_ready(const Unit&) const {}
    __device__ __forceinline__ void done(const Unit&) const {}
};
template <class Epi, class Sched, bool ALIGN_EPI = false, bool SP2 = false>
__device__ __forceinline__ void gemm_phase(PG8_LAS unsigned char* lds, const Gemm g, const Sched& S, const Epi& E) {
    int tid_ = threadIdx.x; asm volatile("" : "+v"(tid_));
    const int tid = tid_, wid = __builtin_amdgcn_readfirstlane(tid >> 6), lane = tid & 63, wr = wid >> 2, wc = wid & 3, fr = lane & 15, fq = lane >> 4;
    const int K = g.K, nt = K / BK;
    unsigned voffA[2], voffB[2];
#pragma unroll
    for (int i = 0; i < 2; ++i) { int R, C; stage_rc(tid * 16 + i * 8192, R, C); const int Rb = Epi::PERM ? ((R & ~31) + perm32(R & 31)) : R;
        voffA[i] = (unsigned)(R * K + C) * 2u; voffB[i] = (unsigned)(Rb * K + C) * 2u; }
    const size_t kstep = (size_t)(BK * 2);
    const size_t hstep = (size_t)HALF * K * 2;
    const size_t tstep = 2 * hstep;
    const unsigned ldsw = (unsigned)wid * 1024u;
    const int aoff = lds_byte(wr * 64 + fr, fq * 8), boff = lds_byte(wc * 32 + fr, fq * 8);
#define PG8_SA(b, h) (((b) * 2 + (h)) * HTB)
#define PG8_SB(b, h) ((4 + (b) * 2 + (h)) * HTB)
#define PG8_STAGE(bufoff, gbase, voff) do { _Pragma("unroll") for (int _i = 0; _i < 2; ++_i) \
        __builtin_amdgcn_global_load_lds((const unsigned*)((const char*)(gbase) + (voff)[_i]), (PG8_LAS unsigned*)(lds + (bufoff) + ldsw + _i * 8192), 16, 0, 0); } while (0)
#define PG8_LDA(dst, b, h) do { _Pragma("unroll") for (int m = 0; m < 4; ++m) _Pragma("unroll") for (int k = 0; k < 2; ++k) dst[m][k] = *(const PG8_LAS bf16x8*)(lds + PG8_SA(b, h) + aoff + m * 2048 + k * 1024); } while (0)
#define PG8_LDB(dst, b, h) do { _Pragma("unroll") for (int n = 0; n < 2; ++n) _Pragma("unroll") for (int k = 0; k < 2; ++k) dst[n][k] = *(const PG8_LAS bf16x8*)(lds + PG8_SB(b, h) + boff + n * 2048 + k * 1024); } while (0)
#define PG8_MMA(ai, bj, At, Bt) do { __builtin_amdgcn_s_setprio(1); _Pragma("unroll") for (int m = 0; m < 4; ++m) _Pragma("unroll") for (int n = 0; n < 2; ++n) _Pragma("unroll") for (int k = 0; k < 2; ++k) \
        acc[ai][bj][m][n] = __builtin_amdgcn_mfma_f32_16x16x32_bf16(Bt[n][k], At[m][k], acc[ai][bj][m][n], 0, 0, 0); __builtin_amdgcn_s_setprio(0); } while (0)
#define PG8_WAIT_V(n) asm volatile("s_waitcnt vmcnt(" #n ")" ::: "memory")
#define PG8_WAIT_L(n) asm volatile("s_waitcnt lgkmcnt(" #n ")" ::: "memory")
#define PG8_BAR __builtin_amdgcn_s_barrier()
#define PG8_SCHED __builtin_amdgcn_sched_barrier(0)
    Unit cur, nxt; int ui = 0;
    if (!S.next(0, cur)) return;
    f32x4 acc[2][2][4][2];
#pragma unroll
    for (int a = 0; a < 2; ++a)
#pragma unroll
        for (int b = 0; b < 2; ++b)
#pragma unroll
            for (int m = 0; m < 4; ++m)
#pragma unroll
                for (int n = 0; n < 2; ++n) acc[a][b][m][n] = (f32x4){0.f, 0.f, 0.f, 0.f};
    bf16x8 At[4][2], B0[2][2], B1[2][2];
    const char* cA = (const char*)g.A + (size_t)cur.pm * tstep; const char* cB = (const char*)g.Bt + (size_t)cur.pn * tstep;
    S.a_ready(cur);
    if constexpr (SP2) {
        PG8_STAGE(PG8_SB(0, 0), cB, voffB); PG8_STAGE(PG8_SB(0, 1), cB + hstep, voffB); PG8_STAGE(PG8_SA(0, 0), cA, voffA); PG8_STAGE(PG8_SA(0, 1), cA + hstep, voffA);
        if (wr == 1) PG8_BAR;
        PG8_WAIT_V(2); PG8_BAR;
        PG8_STAGE(PG8_SB(1, 0), cB + kstep, voffB); PG8_STAGE(PG8_SA(1, 0), cA + kstep, voffA); PG8_STAGE(PG8_SB(1, 1), cB + hstep + kstep, voffB);
        PG8_WAIT_V(6); PG8_BAR;
    } else {
        PG8_STAGE(PG8_SB(0, 0), cB, voffB); PG8_STAGE(PG8_SA(0, 0), cA, voffA); PG8_STAGE(PG8_SB(0, 1), cB + hstep, voffB); PG8_STAGE(PG8_SA(0, 1), cA + hstep, voffA);
        if (wr == 1) PG8_BAR;
        PG8_WAIT_V(4); PG8_BAR;
        PG8_STAGE(PG8_SB(1, 0), cB + kstep, voffB); PG8_STAGE(PG8_SA(1, 0), cA + kstep, voffA); PG8_STAGE(PG8_SB(1, 1), cB + hstep + kstep, voffB);
        PG8_WAIT_V(6); PG8_BAR;
    }
    for (;;) {
        const bool has_next = S.next(ui + 1, nxt);
        const char* nA = has_next ? (const char*)g.A + (size_t)nxt.pm * tstep : cA; const char* nB = has_next ? (const char*)g.Bt + (size_t)nxt.pn * tstep : cB;
#pragma nounroll
        for (int t = 0; t < nt; t += 2) {
            const bool last = (t == nt - 2);
            const char* a1 = cA + (size_t)(t + 1) * kstep;
            const char* a2 = last ? nA : cA + (size_t)(t + 2) * kstep; const char* b2 = last ? nB : cB + (size_t)(t + 2) * kstep;
            const char* a3 = a2 + kstep; const char* b3 = b2 + kstep;
            if (last && has_next) S.a_ready(nxt);
            if constexpr (SP2) {
            PG8_LDB(B0, 0, 0); PG8_LDB(B1, 0, 1); PG8_SCHED; PG8_LDA(At, 0, 0); PG8_STAGE(PG8_SA(1, 1), a1 + hstep, voffA);
            PG8_WAIT_V(8); PG8_WAIT_L(0); PG8_BAR; PG8_MMA(0, 0, At, B0); PG8_MMA(0, 1, At, B1); PG8_BAR; PG8_SCHED;
            PG8_LDA(At, 0, 1); PG8_STAGE(PG8_SB(0, 0), b2, voffB); PG8_STAGE(PG8_SB(0, 1), b2 + hstep, voffB); PG8_STAGE(PG8_SA(0, 0), a2, voffA);
            PG8_WAIT_V(8); PG8_WAIT_L(0); PG8_BAR; PG8_MMA(1, 0, At, B0); PG8_MMA(1, 1, At, B1); PG8_BAR; PG8_SCHED;
            PG8_LDB(B0, 1, 0); PG8_LDB(B1, 1, 1); PG8_SCHED; PG8_LDA(At, 1, 0); PG8_STAGE(PG8_SA(0, 1), a2 + hstep, voffA);
            PG8_WAIT_V(8); PG8_WAIT_L(0); PG8_BAR; PG8_MMA(0, 0, At, B0); PG8_MMA(0, 1, At, B1); PG8_BAR; PG8_SCHED;
            PG8_LDA(At, 1, 1); PG8_STAGE(PG8_SB(1, 0), b3, voffB); PG8_STAGE(PG8_SB(1, 1), b3 + hstep, voffB); PG8_STAGE(PG8_SA(1, 0), a3, voffA);
            PG8_WAIT_V(8); PG8_WAIT_L(0); PG8_BAR; PG8_MMA(1, 0, At, B0); PG8_MMA(1, 1, At, B1); PG8_BAR; PG8_SCHED;
            } else {
            PG8_LDB(B0, 0, 0); PG8_SCHED; PG8_LDA(At, 0, 0); PG8_STAGE(PG8_SA(1, 1), a1 + hstep, voffA);
            PG8_WAIT_L(8); PG8_BAR; PG8_WAIT_L(0); PG8_MMA(0, 0, At, B0); PG8_BAR; PG8_SCHED;
            PG8_LDB(B1, 0, 1); PG8_STAGE(PG8_SB(0, 0), b2, voffB);
            PG8_BAR; PG8_WAIT_L(0); PG8_MMA(0, 1, At, B1); PG8_BAR;
            PG8_LDA(At, 0, 1); PG8_STAGE(PG8_SA(0, 0), a2, voffA);
            PG8_BAR; PG8_WAIT_L(0); PG8_MMA(1, 0, At, B0); PG8_BAR; PG8_SCHED;
            PG8_STAGE(PG8_SB(0, 1), b2 + hstep, voffB);
            PG8_WAIT_V(6); PG8_BAR; PG8_MMA(1, 1, At, B1); PG8_BAR;
            PG8_LDB(B0, 1, 0); PG8_SCHED; PG8_LDA(At, 1, 0); PG8_STAGE(PG8_SA(0, 1), a2 + hstep, voffA);
            PG8_WAIT_L(8); PG8_BAR; PG8_WAIT_L(0); PG8_MMA(0, 0, At, B0); PG8_BAR; PG8_SCHED;
            PG8_LDB(B1, 1, 1); PG8_STAGE(PG8_SB(1, 0), b3, voffB);
            PG8_BAR; PG8_WAIT_L(0); PG8_MMA(0, 1, At, B1); PG8_BAR;
            PG8_LDA(At, 1, 1); PG8_STAGE(PG8_SA(1, 0), a3, voffA);
            PG8_BAR; PG8_WAIT_L(0); PG8_MMA(1, 0, At, B0); PG8_BAR; PG8_SCHED;
            PG8_STAGE(PG8_SB(1, 1), b3 + hstep, voffB);
            PG8_WAIT_V(6); PG8_BAR; PG8_MMA(1, 1, At, B1); PG8_BAR;
            }
        }
        if constexpr (ALIGN_EPI) { if (wr == 0) PG8_BAR; }
        if constexpr (!Epi::AFTER_DRAIN) { E(acc, cur, wr, wc, fr, fq); S.done(cur); }
        if (!has_next) break;
#pragma unroll
        for (int a = 0; a < 2; ++a)
#pragma unroll
            for (int b = 0; b < 2; ++b)
#pragma unroll
                for (int m = 0; m < 4; ++m)
#pragma unroll
                    for (int n = 0; n < 2; ++n) acc[a][b][m][n] = (f32x4){0.f, 0.f, 0.f, 0.f};
        cur = nxt; cA = nA; cB = nB; ++ui;
        if constexpr (ALIGN_EPI) { if (wr == 1) PG8_BAR; }
    }
    PG8_WAIT_V(0);
    if constexpr (!ALIGN_EPI) { if (wr == 0) PG8_BAR; }
    PG8_BAR;
    if constexpr (Epi::AFTER_DRAIN) { E.fused(acc, cur, wr, wc, fr, fq, lds, wid, lane); S.done(cur); }
#undef PG8_SA
#undef PG8_SB
#undef PG8_STAGE
#undef PG8_LDA
#undef PG8_LDB
#undef PG8_MMA
#undef PG8_WAIT_V
#undef PG8_WAIT_L
#undef PG8_BAR
#undef PG8_SCHED
}
}
#ifndef REP_SCAN
#define REP_SCAN 1
#endif
#ifndef REP_ATTN
#define REP_ATTN 1
#endif
#ifndef REP_HELP
#define REP_HELP 1
#endif
#ifndef REP_P4
#define REP_P4 1
#endif
#ifndef REP_P1
#define REP_P1 1
#endif
#ifndef REP_P2
#define REP_P2 1
#endif
#ifndef REP_CHAIN
#define REP_CHAIN 1
#endif
#ifndef PG8_SP2
#define PG8_SP2 true
#endif
#ifndef PG8_ALIGN
#define PG8_ALIGN true
#endif
constexpr int NWAVES = 8;
constexpr int BATCH = 16, T = 4096, D = 1024, M = BATCH * T;
constexpr int INW = 2560, FF = 4096, NLORA = 1536, KLORA = 256;
constexpr int ZR0 = 768;
constexpr float RMS_EPS = 1e-6f, GN_EPS = 64e-5f;
constexpr size_t MiB = 1u << 20;
constexpr size_t WS_WIN = 2 * MiB, WS_WOUT = 8 * MiB, WS_WUP = 10 * MiB, WS_WDOWN = 18 * MiB, WS_BL = 26 * MiB;
constexpr size_t WS_MIX = 32 * MiB, WS_XN = 160 * MiB, WS_Z = 288 * MiB, WS_ALORA = 608 * MiB, WS_LORA = 640 * MiB, WS_H = 288 * MiB, WS_PB = 832 * MiB, WS_QB = 896 * MiB, WS_END = 960 * MiB;
constexpr int LDS_BYTES = 147456;

#define GAS __attribute__((address_space(1)))
#define LAS __attribute__((address_space(3)))
typedef unsigned short bf16;
typedef unsigned v4u __attribute__((ext_vector_type(4)));
typedef unsigned v2u __attribute__((ext_vector_type(2)));
typedef float f32x4 __attribute__((ext_vector_type(4)));
typedef float f32x2 __attribute__((ext_vector_type(2)));
typedef float f32x16 __attribute__((ext_vector_type(16)));
typedef short bf16x8 __attribute__((ext_vector_type(8)));
typedef short s16x4 __attribute__((ext_vector_type(4)));
#define LDS_WAIT() asm volatile("s_waitcnt lgkmcnt(0)" ::: "memory")
#define VM_WAIT() asm volatile("s_waitcnt vmcnt(0)" ::: "memory")
typedef __bf16 bf16x2_t __attribute__((ext_vector_type(2)));
__device__ __forceinline__ unsigned f2bf(float f) { return (unsigned)__builtin_bit_cast(unsigned short, (__bf16)f); }
__device__ __forceinline__ unsigned pk2(float lo, float hi) { const bf16x2_t v = __builtin_convertvector((f32x2){lo, hi}, bf16x2_t); return __builtin_bit_cast(unsigned, v); }
__device__ __forceinline__ float bf2f(unsigned short b) { return __builtin_bit_cast(float, (unsigned)b << 16); }
__device__ __forceinline__ float bflo(unsigned w) { return __builtin_bit_cast(float, w << 16); }
__device__ __forceinline__ float bfhi(unsigned w) { return __builtin_bit_cast(float, w & 0xffff0000u); }
__device__ __forceinline__ float wave_sum(float v) {
#pragma unroll
    for (int o = 1; o < 64; o <<= 1) v += __shfl_xor(v, o);
    return v;
}
template <int CTRL, int RM = 0xF> __device__ __forceinline__ float dppf(float v) { return __builtin_bit_cast(float, __builtin_amdgcn_update_dpp(0, __builtin_bit_cast(int, v), CTRL, RM, 0xF, true)); }
__device__ __forceinline__ float red16(float v) { v += dppf<0xB1>(v); v += dppf<0x4E>(v); v += dppf<0x141>(v); v += dppf<0x140>(v); return v; }
__device__ __forceinline__ float red4(float v) { v += dppf<0xB1>(v); v += dppf<0x4E>(v); return v; }
__device__ __forceinline__ float red8(float v) { v += dppf<0xB1>(v); v += dppf<0x4E>(v); v += dppf<0x141>(v); return v; }
__device__ __forceinline__ float wsum(float v) {
    v += dppf<0xB1>(v); v += dppf<0x4E>(v); v += dppf<0x141>(v); v += dppf<0x140>(v);
    v += dppf<0x142, 0xA>(v); v += dppf<0x143, 0xC>(v);
    return __builtin_bit_cast(float, __builtin_amdgcn_readlane(__builtin_bit_cast(int, v), 63));
}
__device__ __forceinline__ float sigmoidf_(float x) { return __builtin_amdgcn_rcpf(1.0f + __expf(-x)); }
#define WG_BAR_LDS() do { asm volatile("s_waitcnt lgkmcnt(0)" ::: "memory"); __builtin_amdgcn_s_barrier(); asm volatile("" ::: "memory"); } while (0)
__device__ __forceinline__ void wg_global_sync() { VM_WAIT(); __syncthreads(); __builtin_amdgcn_fence(__ATOMIC_ACQUIRE, "agent"); VM_WAIT(); }

struct Args { const float* in[20]; float* out; unsigned char* ws; };
#define RLX_AGENT __ATOMIC_RELAXED, __HIP_MEMORY_SCOPE_AGENT
#define XB_TMO      128
#define XB_XCNT(j)  (256  + 64 * (j))
#define XB_XSUB(j)  (1280 + 64 * (j))
#define XB_XGEN(j)  (2304 + 64 * (j))
#define XB_TOP      3328
#define XB_TOPGEN   3392
#define XCD_BAR_WORDS 3456
#define XB_SPIN_CAP (1u << 18)

__device__ __forceinline__ unsigned xb_ld(unsigned* p)              { return __hip_atomic_load(p, __ATOMIC_RELAXED, __HIP_MEMORY_SCOPE_AGENT); }
__device__ __forceinline__ unsigned xb_add(unsigned* p, unsigned v) { return __hip_atomic_fetch_add(p, v, __ATOMIC_RELAXED, __HIP_MEMORY_SCOPE_AGENT); }
__device__ __forceinline__ unsigned xb_xcc_id() { return (unsigned)__builtin_amdgcn_s_getreg((3 << 11) | 20) & 0xFu; }
#define XB_SPIN(cond, bar) do { unsigned _sp = 0; while (cond) { __builtin_amdgcn_s_sleep(1); \
    if ((++_sp & 255u) == 0u) { if (xb_ld(&(bar)[XB_TMO])) break; if (_sp > XB_SPIN_CAP) { atomicAdd(&(bar)[XB_TMO], 1u); break; } } } } while (0)

struct XcdBarrier {
    unsigned* bar; unsigned x;
    volatile LAS unsigned* st;
};

__device__ __forceinline__ XcdBarrier xcd_barrier_post(unsigned* bar, volatile LAS unsigned* st) {
    XcdBarrier b; b.bar = bar; b.x = xb_xcc_id(); b.st = st;
    if (threadIdx.x == 0) (void)xb_add(&bar[XB_XCNT(b.x)], 1u);
    return b;
}
__device__ __forceinline__ void xcd_barrier_complete(unsigned* bar, unsigned x, unsigned& nloc, unsigned& nx) {
    const unsigned G = gridDim.x * gridDim.y * gridDim.z;
    unsigned sum, cnt, mine, sp = 0u;
    for (;;) {
        sum = 0u; cnt = 0u; mine = 0u;
#pragma unroll
        for (unsigned j = 0; j < 16; ++j) { const unsigned c = xb_ld(&bar[XB_XCNT(j)]); sum += c; cnt += (c > 0u) ? 1u : 0u; mine = (j == x) ? c : mine; }
        if (sum == G) break;
        __builtin_amdgcn_s_sleep(1);
        if ((++sp & 255u) == 0u) { if (xb_ld(&bar[XB_TMO])) break; if (sp > XB_SPIN_CAP) { atomicAdd(&bar[XB_TMO], 1u); break; } }
    }
    nloc = mine > 0u ? mine : 1u; nx = cnt > 0u ? cnt : 1u;
}

__device__ __forceinline__ void xcd_barrier(const XcdBarrier& b) {
    asm volatile("s_waitcnt vmcnt(0)" ::: "memory");
    __syncthreads();
    if (threadIdx.x == 0) {
        unsigned* bar = b.bar;
        __builtin_amdgcn_s_waitcnt(0);
        unsigned nloc = b.st[0], nx = b.st[1];
        if (nloc == 0u) { xcd_barrier_complete(bar, b.x, nloc, nx); b.st[0] = nloc; b.st[1] = nx; }
        const unsigned old = xb_add(&bar[XB_XSUB(b.x)], 1u);
        const unsigned gen = old / nloc;
        if (old + 1u == (gen + 1u) * nloc) {
            __builtin_amdgcn_fence(__ATOMIC_RELEASE, "agent");
            asm volatile("s_waitcnt vmcnt(0)" ::: "memory");
            const unsigned og = xb_add(&bar[XB_TOP], 1u);
            const unsigned tg = og / nx;
            if (og + 1u == (tg + 1u) * nx) xb_add(&bar[XB_TOPGEN], 1u);
            else XB_SPIN(xb_ld(&bar[XB_TOPGEN]) == tg, bar);
            __builtin_amdgcn_fence(__ATOMIC_ACQUIRE, "agent");
            xb_add(&bar[XB_XGEN(b.x)], 1u);
            asm volatile("s_waitcnt vmcnt(0)" ::: "memory");
        } else {
            XB_SPIN(xb_ld(&bar[XB_XGEN(b.x)]) == gen, bar);
            __builtin_amdgcn_fence(__ATOMIC_ACQUIRE, "agent");
            asm volatile("s_waitcnt vmcnt(0)" ::: "memory");
        }
    }
    __syncthreads();
}

__device__ __forceinline__ void team_barrier(unsigned* cnt, unsigned np) {
    VM_WAIT(); __syncthreads();
    if (threadIdx.x == 0) {
        __builtin_amdgcn_fence(__ATOMIC_RELEASE, "agent"); VM_WAIT();
        __hip_atomic_fetch_add(cnt, 1u, __ATOMIC_RELAXED, __HIP_MEMORY_SCOPE_AGENT);
        unsigned sp = 0;
        while (__hip_atomic_load(cnt, __ATOMIC_RELAXED, __HIP_MEMORY_SCOPE_AGENT) < np) { __builtin_amdgcn_s_sleep(2); if (++sp > (1u << 22)) break; }
        __builtin_amdgcn_fence(__ATOMIC_ACQUIRE, "agent"); VM_WAIT();
    }
    __syncthreads();
}
__device__ __forceinline__ void p0_transpose_item(const float* W, int K, int N, bf16* WT, LAS float* scr, int item, int lane) {
    const int nblk = N / 32, kb = item / nblk, nb = item % nblk, k0 = 64 * kb, n0 = 32 * nb;
#pragma unroll 8
    for (int i = 0; i < 32; ++i) { const int kk = 2 * i + (lane >> 5); scr[kk * 33 + (lane & 31)] = W[(size_t)(k0 + kk) * N + n0 + (lane & 31)]; }
    LDS_WAIT(); asm volatile("" ::: "memory");
    const int c = lane & 7;
#pragma unroll
    for (int j = 0; j < 4; ++j) { const int n = (lane >> 3) + 8 * j; const LAS float* s = scr + (8 * c) * 33 + n;
        v4u o; o.x = pk2(s[0 * 33], s[1 * 33]); o.y = pk2(s[2 * 33], s[3 * 33]); o.z = pk2(s[4 * 33], s[5 * 33]); o.w = pk2(s[6 * 33], s[7 * 33]);
        *(GAS v4u*)(WT + (size_t)(n0 + n) * K + k0 + 8 * c) = o; }
    LDS_WAIT(); asm volatile("" ::: "memory");
}
template <int NR> __device__ __forceinline__ void rms_rows_to_bf16(const float* x0, size_t xstride, const float* g, bf16* o0, size_t ostride, int lane) {
    const GAS f32x4* gr = (const GAS f32x4*)g + lane;
    f32x4 v[NR][4]; float s[NR];
#pragma unroll
    for (int r = 0; r < NR; ++r) { const GAS f32x4* xr = (const GAS f32x4*)(x0 + r * xstride) + lane;
#pragma unroll
        for (int j = 0; j < 4; ++j) v[r][j] = xr[64 * j]; }
#pragma unroll
    for (int r = 0; r < NR; ++r) { float a = 0.f;
#pragma unroll
        for (int j = 0; j < 4; ++j) a += (v[r][j].x * v[r][j].x + v[r][j].y * v[r][j].y) + (v[r][j].z * v[r][j].z + v[r][j].w * v[r][j].w);
        s[r] = a; }
#pragma unroll
    for (int r = 0; r < NR; ++r) { const float rstd = __builtin_amdgcn_rsqf(wsum(s[r]) * (1.f / D) + RMS_EPS);
        GAS unsigned long long* o8 = (GAS unsigned long long*)(o0 + r * ostride) + lane;
#pragma unroll
        for (int j = 0; j < 4; ++j) { const f32x4 gg = gr[64 * j]; o8[64 * j] = (unsigned long long)pk2(v[r][j].x * rstd * gg.x, v[r][j].y * rstd * gg.y) | ((unsigned long long)pk2(v[r][j].z * rstd * gg.z, v[r][j].w * rstd * gg.w) << 32); } }
}
template <int NR> __device__ __forceinline__ void rms_rows_inplace(float* x0, size_t xstride, const float* g, int lane) {
    const GAS f32x4* gr = (const GAS f32x4*)g + lane;
    f32x4 v[NR][4]; float s[NR];
#pragma unroll
    for (int r = 0; r < NR; ++r) { const GAS f32x4* xr = (const GAS f32x4*)(x0 + r * xstride) + lane;
#pragma unroll
        for (int j = 0; j < 4; ++j) v[r][j] = xr[64 * j]; }
#pragma unroll
    for (int r = 0; r < NR; ++r) { float a = 0.f;
#pragma unroll
        for (int j = 0; j < 4; ++j) a += (v[r][j].x * v[r][j].x + v[r][j].y * v[r][j].y) + (v[r][j].z * v[r][j].z + v[r][j].w * v[r][j].w);
        s[r] = a; }
#pragma unroll
    for (int r = 0; r < NR; ++r) { const float rstd = __builtin_amdgcn_rsqf(wsum(s[r]) * (1.f / D) + RMS_EPS);
        GAS f32x4* xr = (GAS f32x4*)(x0 + r * xstride) + lane;
#pragma unroll
        for (int j = 0; j < 4; ++j) { const f32x4 gg = gr[64 * j]; xr[64 * j] = v[r][j] * rstd * gg; } }
}

__device__ __forceinline__ void lora_in_row(const bf16* Z, const float* mu, bf16* AL, int m, int lane) {
    const int c = 4 * lane;
    const v2u zc = *(const GAS v2u*)(Z + (size_t)m * INW + 2304 + c);
    const bool hasp = (m % T) != 0;
    const v2u zp = *(const GAS v2u*)(Z + (size_t)(hasp ? m - 1 : m) * INW + 2304 + c);
    const float fac = hasp ? 1.f : 0.f;
    const f32x4 mv = *(const GAS f32x4*)(mu + 1536 + c);
    float z[4] = {bflo(zc.x), bfhi(zc.x), bflo(zc.y), bfhi(zc.y)}, p[4] = {bflo(zp.x) * fac, bfhi(zp.x) * fac, bflo(zp.y) * fac, bfhi(zp.y) * fac}, o[4];
#pragma unroll
    for (int j = 0; j < 4; ++j) { const float v = z[j] + (p[j] - z[j]) * mv[j];
        o[j] = (c < 64) ? (1.f - 2.f / (1.f + __expf(2.f * v))) : ((c < 128) ? v : sigmoidf_(v)); }
    v2u w; w.x = pk2(o[0], o[1]); w.y = pk2(o[2], o[3]);
    *(GAS v2u*)(AL + (size_t)m * KLORA + c) = w;
}

constexpr int AT_KSTR = 144, AT_VSTR = 520, AT_VOFF = 256 * AT_KSTR;
__device__ __forceinline__ int crow(int r, int hi) { return (r & 3) + 8 * (r >> 2) + 4 * hi; }
__device__ __forceinline__ void attn_unit(LAS unsigned char* lds, const bf16* Z, bf16* MIX, const float* sinks, int b, int nb, int kvh) {
    const int tid = threadIdx.x, wid = __builtin_amdgcn_readfirstlane(tid >> 6), lane = tid & 63;
    __syncthreads();
#pragma unroll
    for (int i = 0; i < 4; ++i) {
        const int chunk = tid + 512 * i, key = chunk >> 3, c8 = chunk & 7, kpos = nb * 128 - 128 + key;
        v4u kv = (v4u){0u, 0u, 0u, 0u}, vv = (v4u){0u, 0u, 0u, 0u};
        if (kpos >= 0) { const bf16* zr = Z + (size_t)(b * T + kpos) * INW + 512 + kvh * 64 + c8 * 8; kv = *(const GAS v4u*)zr; vv = *(const GAS v4u*)(zr + 128); }
        *(LAS v4u*)(lds + key * AT_KSTR + c8 * 16) = kv;
        LAS unsigned short* vt = (LAS unsigned short*)(lds + AT_VOFF + (c8 * 8) * AT_VSTR + key * 2);
#pragma unroll
        for (int e = 0; e < 4; ++e) { vt[(2 * e) * (AT_VSTR / 2)] = (unsigned short)(vv[e] & 0xffffu); vt[(2 * e + 1) * (AT_VSTR / 2)] = (unsigned short)(vv[e] >> 16); }
    }
    __syncthreads();
    const int g = wid >> 1, hq = kvh * 4 + g, qhalf = wid & 1, q = lane & 31, hh = lane >> 5;
    const float slope = exp2f(-(float)(hq + 1)), sink = sinks[hq];
    for (int qt = 0; qt < 2; ++qt) {
        const int q0 = qhalf * 64 + qt * 32, qi = q0 + q, kt0 = q0 >> 5; const size_t m = (size_t)b * T + nb * 128 + qi;
        bf16x8 qf[4];
#pragma unroll
        for (int s = 0; s < 4; ++s) qf[s] = *(const GAS bf16x8*)(Z + m * INW + hq * 64 + 16 * s + 8 * hh);
        f32x16 sc[5];
#pragma unroll
        for (int i = 0; i < 5; ++i) {
#pragma unroll
            for (int r = 0; r < 16; ++r) sc[i][r] = 0.f;
#pragma unroll
            for (int s = 0; s < 4; ++s) { const bf16x8 a = *(const LAS bf16x8*)(lds + (32 * (kt0 + i) + q) * AT_KSTR + (16 * s + 8 * hh) * 2); sc[i] = __builtin_amdgcn_mfma_f32_32x32x16_bf16(a, qf[s], sc[i], 0, 0, 0); }
        }
        float mx = -1e30f;
#pragma unroll
        for (int i = 0; i < 5; ++i)
#pragma unroll
            for (int r = 0; r < 16; ++r) { const int kj = 32 * (kt0 + i) + crow(r, hh), dist = qi - kj + 128; const bool valid = (dist >= 0) && (dist < 128) && (nb * 128 - 128 + kj >= 0);
                const float v = valid ? (sc[i][r] * 0.125f - slope * (float)dist) : -1e30f; sc[i][r] = v; mx = fmaxf(mx, v); }
        mx = fmaxf(mx, __shfl_xor(mx, 32)); mx = fmaxf(mx, sink);
        float sum = 0.f;
#pragma unroll
        for (int i = 0; i < 5; ++i)
#pragma unroll
            for (int r = 0; r < 16; ++r) { const float e = __expf(sc[i][r] - mx); sc[i][r] = e; sum += e; }
        sum += __shfl_xor(sum, 32);
        const float inv = 1.0f / (sum + __expf(sink - mx));
        f32x16 o[2];
#pragma unroll
        for (int r = 0; r < 16; ++r) { o[0][r] = 0.f; o[1][r] = 0.f; }
#pragma unroll
        for (int i = 0; i < 5; ++i)
#pragma unroll
            for (int s = 0; s < 2; ++s) {
                v4u pw;
#pragma unroll
                for (int j = 0; j < 4; ++j) pw[j] = pk2(sc[i][8 * s + 2 * j] * inv, sc[i][8 * s + 2 * j + 1] * inv);
                const bf16x8 xs = __builtin_bit_cast(bf16x8, pw);
                const int kb = 32 * (kt0 + i) + 16 * s + 4 * hh;
#pragma unroll
                for (int dt = 0; dt < 2; ++dt) { const LAS unsigned char* vp = lds + AT_VOFF + (dt * 32 + q) * AT_VSTR + kb * 2;
                    const s16x4 lo = *(const LAS s16x4*)vp, hi = *(const LAS s16x4*)(vp + 16);
                    const bf16x8 pa = __builtin_shufflevector(lo, hi, 0, 1, 2, 3, 4, 5, 6, 7);
                    o[dt] = __builtin_amdgcn_mfma_f32_32x32x16_bf16(pa, xs, o[dt], 0, 0, 0); }
            }
        bf16* orow = MIX + m * D + hq * 64 + 4 * hh;
#pragma unroll
        for (int dt = 0; dt < 2; ++dt)
#pragma unroll
            for (int r4 = 0; r4 < 4; ++r4) { v2u w; w.x = pk2(o[dt][4 * r4], o[dt][4 * r4 + 1]); w.y = pk2(o[dt][4 * r4 + 2], o[dt][4 * r4 + 3]); *(GAS v2u*)(orow + dt * 32 + 8 * r4) = w; }
    }
}

constexpr int TC = 16, NCH = T / TC;
constexpr int SC_W = 0, SC_A = TC * 64, SC_B = 2 * TC * 64, SC_K = 3 * TC * 64, SC_R = 4 * TC * 64, SC_V = 5 * TC * 64, SC_G = 6 * TC * 64, SC_BON = 7 * TC * 64, SC_YP = 7 * TC * 64 + 64, SC_BUF = SC_YP + TC * 32 * 4;
static_assert(2 * SC_BUF * 4 <= 131072, "scan LDS");
struct ScanConst { f32x4 mu_r, mu_k, mu_v, w0, a0, kk, ka, rk; };
struct ScanRaw { v2u zr[3], zp[3], lo[3]; float fac; };
__device__ __forceinline__ f32x4 unpack4(v2u p) { return (f32x4){bflo(p.x), bfhi(p.x), bflo(p.y), bfhi(p.y)}; }
__device__ __forceinline__ float sum4(f32x4 v) { return (v.x + v.y) + (v.z + v.w); }
__device__ __forceinline__ void scan_load(ScanRaw& R, const bf16* Z, const bf16* LORA, int b, int h, int t0, int k4, int lane) {
    const int t = 4 * k4 + (lane >> 4), hc = h * 64 + 4 * (lane & 15); const size_t m = (size_t)b * T + t0 + t; const bool hasp = (t0 + t) > 0; R.fac = hasp ? 1.f : 0.f;
    const bf16* zrow = Z + m * INW + ZR0 + hc; const bf16* prow = hasp ? zrow - INW : zrow; const bf16* lrow = LORA + m * NLORA + hc;
#pragma unroll
    for (int j = 0; j < 3; ++j) { R.zr[j] = *(const GAS v2u*)(zrow + 512 * j); R.zp[j] = *(const GAS v2u*)(prow + 512 * j); R.lo[j] = *(const GAS v2u*)(lrow + 512 * j); }
}
__device__ __forceinline__ void scan_store(LAS float* buf, const ScanRaw& R, int k4, int lane, const ScanConst& c) {
    const int t = 4 * k4 + (lane >> 4), cg = lane & 15;
    const f32x4 zr = unpack4(R.zr[0]), zk = unpack4(R.zr[1]), zv = unpack4(R.zr[2]);
    const f32x4 xr = zr + (unpack4(R.zp[0]) * R.fac - zr) * c.mu_r, xk = zk + (unpack4(R.zp[1]) * R.fac - zk) * c.mu_k, xv = zv + (unpack4(R.zp[2]) * R.fac - zv) * c.mu_v;
    const f32x4 lw = unpack4(R.lo[0]) + c.w0, la = unpack4(R.lo[1]) + c.a0, g = unpack4(R.lo[2]);
    f32x4 w, a;
#pragma unroll
    for (int e = 0; e < 4; ++e) { w[e] = __expf(-0.60653066f * sigmoidf_(lw[e])); a[e] = sigmoidf_(la[e]); }
    const f32x4 kkr = xk * c.kk; const float ss = red16(sum4(kkr * kkr)); const f32x4 kk = kkr * __builtin_amdgcn_rsqf(fmaxf(ss, 1e-24f));
    const f32x4 k = xk * (1.f + (a - 1.f) * c.ka);
    const float bon = red16(sum4(xr * k * c.rk));
    *(LAS f32x4*)(buf + SC_W + t * 64 + 4 * cg) = w; *(LAS f32x4*)(buf + SC_A + t * 64 + 4 * cg) = -kk; *(LAS f32x4*)(buf + SC_B + t * 64 + 4 * cg) = kk * a; *(LAS f32x4*)(buf + SC_K + t * 64 + 4 * cg) = k;
    *(LAS f32x4*)(buf + SC_R + t * 64 + 4 * cg) = xr; *(LAS f32x4*)(buf + SC_V + t * 64 + 4 * cg) = xv; *(LAS f32x4*)(buf + SC_G + t * 64 + 4 * cg) = g; if (cg == 0) buf[SC_BON + t] = bon;
}
__device__ __forceinline__ void scan_output(const LAS float* buf, float* Y, bf16* PB, bf16* QB, int b, int h, int half, int t0, int k4, int lane, f32x2 lnw2, f32x2 lnb2) {
    const int t = 4 * k4 + (lane >> 4), cg = lane & 15, row = half * 32 + 2 * cg; const size_t m = (size_t)b * T + t0 + t;
    const LAS f32x4* yp = (const LAS f32x4*)(buf + SC_YP + (t * 32 + 2 * cg) * 4);
    f32x2 y; y.x = sum4(yp[0]); y.y = sum4(yp[1]);
    const f32x2 v = *(const LAS f32x2*)(buf + SC_V + t * 64 + row), g = *(const LAS f32x2*)(buf + SC_G + t * 64 + row);
    const float bon = buf[SC_BON + t];
    const f32x2 P = g * lnw2, Q = (lnb2 + v * bon) * g;
    const size_t off = m * 512 + h * 64 + row;
    *(GAS f32x2*)(Y + off) = y; *(GAS unsigned*)(PB + off) = pk2(P.x, P.y); *(GAS unsigned*)(QB + off) = pk2(Q.x, Q.y);
}
struct ScanOps { f32x4 a, w, b, k, r; float v0, v1; };
__device__ __forceinline__ void scan_ops_load(ScanOps& o, const LAS float* buf, int t, int slice, int vrow) {
    o.a = *(const LAS f32x4*)(buf + SC_A + t * 64 + slice * 4); o.w = *(const LAS f32x4*)(buf + SC_W + t * 64 + slice * 4); o.b = *(const LAS f32x4*)(buf + SC_B + t * 64 + slice * 4);
    o.k = *(const LAS f32x4*)(buf + SC_K + t * 64 + slice * 4); o.r = *(const LAS f32x4*)(buf + SC_R + t * 64 + slice * 4);
    o.v0 = buf[SC_V + t * 64 + vrow]; o.v1 = buf[SC_V + t * 64 + vrow + 16];
}
__device__ __forceinline__ void scan_steps(LAS float* buf, f32x2 (&S0)[2], f32x2 (&S1)[2], int slice, int rq, int vrow) {
    ScanOps cur; scan_ops_load(cur, buf, 0, slice, vrow);
    float yp0 = 0.f, yp1 = 0.f;
#pragma unroll
    for (int t = 0; t < TC; ++t) {
        ScanOps nxt; if (t + 1 < TC) scan_ops_load(nxt, buf, t + 1, slice, vrow);
        __builtin_amdgcn_sched_barrier(0);
        const f32x2 a[2] = {cur.a.xy, cur.a.zw}, w[2] = {cur.w.xy, cur.w.zw}, bb[2] = {cur.b.xy, cur.b.zw}, k[2] = {cur.k.xy, cur.k.zw}, r[2] = {cur.r.xy, cur.r.zw};
        const f32x2 d0 = S0[0] * a[0] + S0[1] * a[1], d1 = S1[0] * a[0] + S1[1] * a[1];
        float e0 = d0.x + d0.y, e1 = d1.x + d1.y;
        e0 += dppf<0xB1>(e0); e1 += dppf<0xB1>(e1); yp0 += dppf<0xB1>(yp0); yp1 += dppf<0xB1>(yp1);
        e0 += dppf<0x4E>(e0); e1 += dppf<0x4E>(e1); yp0 += dppf<0x4E>(yp0); yp1 += dppf<0x4E>(yp1);
        e0 += dppf<0x141>(e0); e1 += dppf<0x141>(e1);
        if (t > 0) { buf[SC_YP + ((t - 1) * 32 + rq) * 4 + (slice >> 2)] = yp0; buf[SC_YP + ((t - 1) * 32 + rq + 16) * 4 + (slice >> 2)] = yp1; }
        e0 += dppf<0x140>(e0); e1 += dppf<0x140>(e1);
        const f32x2 sa0v = {e0, e0}, sa1v = {e1, e1}, v0v = {cur.v0, cur.v0}, v1v = {cur.v1, cur.v1};
#pragma unroll
        for (int q = 0; q < 2; ++q) { S0[q] = S0[q] * w[q] + (sa0v * bb[q] + v0v * k[q]); S1[q] = S1[q] * w[q] + (sa1v * bb[q] + v1v * k[q]); }
        const f32x2 y0 = S0[0] * r[0] + S0[1] * r[1], y1 = S1[0] * r[0] + S1[1] * r[1];
        yp0 = y0.x + y0.y; yp1 = y1.x + y1.y;
        __builtin_amdgcn_sched_barrier(0);
        if (t + 1 < TC) cur = nxt;
    }
    yp0 = red4(yp0); yp1 = red4(yp1);
    buf[SC_YP + ((TC - 1) * 32 + rq) * 4 + (slice >> 2)] = yp0; buf[SC_YP + ((TC - 1) * 32 + rq + 16) * 4 + (slice >> 2)] = yp1;
}
__device__ __forceinline__ void scan_unit(LAS float* lds, const bf16* Z, const bf16* LORA, float* Y, bf16* PB, bf16* QB, const Args& args, int b, int h, int half) {
    const int tid = threadIdx.x, wid = __builtin_amdgcn_readfirstlane(tid >> 6), lane = tid & 63;
    __syncthreads();
    if (wid < 4) {
        const int slice = tid & 15, rq = tid >> 4, vrow = half * 32 + rq;
        f32x2 S0[2], S1[2];
#pragma unroll
        for (int q = 0; q < 2; ++q) { S0[q] = (f32x2){0.f, 0.f}; S1[q] = (f32x2){0.f, 0.f}; }
        WG_BAR_LDS();
        for (int ch = 0; ch < NCH; ++ch) { scan_steps(lds + (ch & 1) * SC_BUF, S0, S1, slice, rq, vrow); WG_BAR_LDS(); }
    } else {
        const int k4 = wid - 4, hc4 = h * 64 + 4 * (lane & 15), row = h * 64 + half * 32 + 2 * (lane & 15);
        ScanConst c; c.mu_r = *(const GAS f32x4*)(args.in[4] + hc4); c.mu_k = *(const GAS f32x4*)(args.in[4] + 512 + hc4); c.mu_v = *(const GAS f32x4*)(args.in[4] + 1024 + hc4); c.w0 = *(const GAS f32x4*)(args.in[5] + hc4); c.a0 = *(const GAS f32x4*)(args.in[7] + hc4);
        c.kk = *(const GAS f32x4*)(args.in[10] + hc4); c.ka = *(const GAS f32x4*)(args.in[11] + hc4); c.rk = *(const GAS f32x4*)(args.in[12] + hc4);
        const f32x2 lnw2 = *(const GAS f32x2*)(args.in[13] + row), lnb2 = *(const GAS f32x2*)(args.in[14] + row);
        ScanRaw Re, Ro; scan_load(Re, Z, LORA, b, h, 0, k4, lane); scan_store(lds, Re, k4, lane, c); scan_load(Ro, Z, LORA, b, h, TC, k4, lane); scan_load(Re, Z, LORA, b, h, 2 * TC, k4, lane);
        WG_BAR_LDS();
        for (int ch = 0; ch < NCH; ch += 2) {
            {
                LAS float* oth = lds + SC_BUF;
                if (ch > 0) scan_output(oth, Y, PB, QB, b, h, half, (ch - 1) * TC, k4, lane, lnw2, lnb2);
                scan_store(oth, Ro, k4, lane, c);
                if (ch + 3 < NCH) scan_load(Ro, Z, LORA, b, h, (ch + 3) * TC, k4, lane);
                WG_BAR_LDS();
            }
            {
                LAS float* oth = lds;
                scan_output(oth, Y, PB, QB, b, h, half, ch * TC, k4, lane, lnw2, lnb2);
                if (ch + 2 < NCH) { scan_store(oth, Re, k4, lane, c); if (ch + 4 < NCH) scan_load(Re, Z, LORA, b, h, (ch + 4) * TC, k4, lane); }
                WG_BAR_LDS();
            }
        }
        scan_output(lds + ((NCH - 1) & 1) * SC_BUF, Y, PB, QB, b, h, half, (NCH - 1) * TC, k4, lane, lnw2, lnb2);
    }
    __syncthreads();
}
__device__ __forceinline__ void rwkv_post_panel(const float* Y, const bf16* PB, const bf16* QB, bf16* MIX, int pm, int wave, int lane) {
    const int tsub = lane >> 4, cg = lane & 15;
    for (int j0 = 0; j0 < 64; j0 += 4) {
        f32x4 y[4]; v2u p[4], q[4];
#pragma unroll
        for (int u = 0; u < 4; ++u) { const size_t off = (size_t)(pm * 256 + (j0 + u) * 4 + tsub) * 512 + wave * 64 + 4 * cg; y[u] = *(const GAS f32x4*)(Y + off); p[u] = *(const GAS v2u*)(PB + off); q[u] = *(const GAS v2u*)(QB + off); }
#pragma unroll
        for (int u = 0; u < 4; ++u) { const size_t m = (size_t)(pm * 256 + (j0 + u) * 4 + tsub);
            const float mean = red16(sum4(y[u])) * (1.f / 64.f); const f32x4 d = y[u] - mean; const float var = red16(sum4(d * d)) * (1.f / 64.f);
            const f32x4 o = d * __builtin_amdgcn_rsqf(var + GN_EPS) * unpack4(p[u]) + unpack4(q[u]);
            v2u pw; pw.x = pk2(o[0], o[1]); pw.y = pk2(o[2], o[3]);
            *(GAS v2u*)(MIX + m * D + 512 + wave * 64 + 4 * cg) = pw; }
    }
}

__global__ void __launch_bounds__(NWAVES * 64, 2) mk_fwd(Args args) {
    extern __shared__ __attribute__((aligned(16))) unsigned char lds_raw[];
    LAS unsigned char* lds = (LAS unsigned char*)lds_raw;
    cg::grid_group grid = cg::this_grid();
    volatile LAS unsigned* bar_st = (volatile LAS unsigned*)(lds + 131072 + 64);
    if (threadIdx.x == 0) { bar_st[0] = 0u; bar_st[1] = 0u; }
    __syncthreads();
    const int tid = threadIdx.x, lane = tid & 63, wave = __builtin_amdgcn_readfirstlane(tid >> 6);
    const int G = gridDim.x, bx = blockIdx.x;
    unsigned char* ws = args.ws;
    const float* x = args.in[0]; float* out = args.out;
    bf16* WIN = (bf16*)(ws + WS_WIN); bf16* WOUT = (bf16*)(ws + WS_WOUT); bf16* WUP = (bf16*)(ws + WS_WUP); bf16* WDOWN = (bf16*)(ws + WS_WDOWN); bf16* BL = (bf16*)(ws + WS_BL);
    bf16* MIX = (bf16*)(ws + WS_MIX); float* Yb = (float*)(ws + WS_XN); bf16* PB = (bf16*)(ws + WS_PB); bf16* QB = (bf16*)(ws + WS_QB); bf16* XN = (bf16*)(ws + WS_XN); bf16* Zb = (bf16*)(ws + WS_Z); bf16* AL = (bf16*)(ws + WS_ALORA); bf16* LORA = (bf16*)(ws + WS_LORA); bf16* HB = (bf16*)(ws + WS_H);

    {
        LAS float* scr = (LAS float*)(lds + wave * 16384);
        const int gw = bx * NWAVES + wave, NGW = G * NWAVES;
        constexpr int I_IN = (D / 64) * (INW / 32), I_OUT = (D / 64) * (D / 32), I_UP = (D / 64) * (FF / 32), I_DN = (FF / 64) * (D / 32);
        constexpr int NITEMS = I_IN + I_OUT + I_UP + I_DN;
        for (int it = gw; it < NITEMS; it += NGW) {
            int r = it;
            if (r < I_IN) { p0_transpose_item(args.in[2], D, INW, WIN, scr, r, lane); continue; } r -= I_IN;
            if (r < I_OUT) { p0_transpose_item(args.in[15], D, D, WOUT, scr, r, lane); continue; } r -= I_OUT;
            if (r < I_UP) { p0_transpose_item(args.in[17], D, FF, WUP, scr, r, lane); continue; } r -= I_UP;
            p0_transpose_item(args.in[18], FF, D, WDOWN, scr, r, lane);
        }
        if (bx == 0) for (int i = tid; i < 16384; i += NWAVES * 64) ((unsigned*)ws)[i] = 0u;
        for (int idx = bx * (NWAVES * 64) + tid; idx < NLORA * KLORA; idx += G * NWAVES * 64) {
            const int n = idx / KLORA, k = idx % KLORA; float v = 0.f;
            if (n < 512) { if (k < 64) v = args.in[6][k * 512 + n]; }
            else if (n < 1024) { if (k >= 64 && k < 128) v = args.in[8][(k - 64) * 512 + (n - 512)]; }
            else { if (k >= 128) v = args.in[9][(k - 128) * 512 + (n - 1024)]; }
            BL[idx] = (bf16)f2bf(v);
        }
        for (int m = gw * 4; m < M; m += NGW * 4) rms_rows_to_bf16<4>(x + (size_t)m * D, D, args.in[1], XN + (size_t)m * D, D, lane);
    }
    grid.sync();
    const XcdBarrier xbar = xcd_barrier_post((unsigned*)ws + 8192, bar_st);
    for (int rep_ = 0; rep_ < REP_P1; ++rep_) {
        pg8::Gemm g{XN, WIN, M, INW, D}; pg8::StaticOrder S; S.init(M, INW, G, bx);
        pg8::EpiBf16<0> E{Zb, INW, nullptr, 0, 0, 1.f};
#ifndef NO_P1
        pg8::gemm_phase<pg8::EpiBf16<0>, pg8::StaticOrder, PG8_ALIGN, PG8_SP2>(lds, g, S, E);
#endif
    }
    xcd_barrier(xbar);
    if (bx < M / 256) { const int pm = bx;
        for (int r = wave * 4; r < 256; r += NWAVES * 4) {
#pragma unroll
            for (int q = 0; q < 4; ++q) lora_in_row(Zb, args.in[4], AL, pm * 256 + r + q, lane); }
        wg_global_sync();
        pg8::Gemm g{AL, BL, M, NLORA, KLORA}; pg8::PanelOrder S{pm, NLORA / 256};
        pg8::EpiBf16<0> E{LORA, NLORA, nullptr, 0, 0, 1.f};
#ifndef NO_P1B
        pg8::gemm_phase<pg8::EpiBf16<0>, pg8::PanelOrder, PG8_ALIGN, PG8_SP2>(lds, g, S, E);
#endif
    }
    xcd_barrier(xbar);
    {
        for (int u = bx; u < BATCH * 32 * 2; u += G) attn_unit(lds, Zb, MIX, args.in[3], u >> 6, (u >> 1) & 31, u & 1);
        for (int u = bx; u < BATCH * 16; u += G) scan_unit((LAS float*)lds, Zb, LORA, Yb, PB, QB, args, u >> 4, (u >> 1) & 7, u & 1);
    }
    xcd_barrier(xbar);
    for (int rep_ = 0; rep_ < REP_CHAIN; ++rep_) if (bx < M / 256) { const int pm = bx;
        rwkv_post_panel(Yb, PB, QB, MIX, pm, wave, lane);
        wg_global_sync();
        { pg8::Gemm g{MIX, WOUT, M, D, D}; pg8::PanelOrder S{pm, D / 256}; pg8::EpiResF32 E{x, out, D};

#ifndef NO_P35
          pg8::gemm_phase<pg8::EpiResF32, pg8::PanelOrder, PG8_ALIGN, PG8_SP2>(lds, g, S, E);
#endif
 }
        wg_global_sync();
        for (int r = wave * 4; r < 256; r += NWAVES * 4) rms_rows_to_bf16<4>(out + (size_t)(pm * 256 + r) * D, D, args.in[16], XN + (size_t)(pm * 256 + r) * D, D, lane);
        wg_global_sync();
        for (int r4_ = 0; r4_ < REP_P4; ++r4_)
        { pg8::Gemm g{XN, WUP, M, FF, D}; pg8::PanelOrder S{pm, FF / 256}; pg8::EpiBf16<2> E{HB, FF, nullptr, 0, 0, 1.f};

#ifndef NO_P4
          pg8::gemm_phase<pg8::EpiBf16<2>, pg8::PanelOrder, PG8_ALIGN, PG8_SP2>(lds, g, S, E);
#endif
 }
        wg_global_sync();
        { const int xq = bx & 7, role = (bx >> 3) & 3, q = bx >> 5; unsigned* tcnt = (unsigned*)ws + (size_t)(q * 8 + xq) * 128;
          team_barrier(tcnt, 4u);
          pg8::Gemm g{HB, WDOWN, M, D, FF}; pg8::TeamOrder S{q * 32 + xq, 8, role, 4, 1}; pg8::EpiResF32 E{out, out, D};
          pg8::gemm_phase<pg8::EpiResF32, pg8::TeamOrder, PG8_ALIGN, PG8_SP2>(lds, g, S, E);
          team_barrier(tcnt + 64, 4u); }
        for (int r = wave * 4; r < 256; r += NWAVES * 4) rms_rows_inplace<4>(out + (size_t)(pm * 256 + r) * D, D, args.in[19], lane);
    }
}

extern "C" void kernel_launch(void* const* d_in, const int* in_sizes, int n_in, void* d_out, int out_size, void* d_ws, size_t ws_size, hipStream_t stream) {
    static int grid = 0;
    if (grid == 0) {
        if (n_in != 20 || in_sizes[0] != M * D || out_size != M * D || ws_size < WS_END) { fprintf(stderr, "kernel_launch: unexpected shapes (n_in %d, in0 %d, out %d, ws %zu)\n", n_in, n_in > 0 ? in_sizes[0] : -1, out_size, ws_size); grid = -1; return; }
        int dev = 0, cus = 0, per_cu = 0;
        if (hipGetDevice(&dev) != hipSuccess || hipDeviceGetAttribute(&cus, hipDeviceAttributeMultiprocessorCount, dev) != hipSuccess) { grid = -1; return; }
        if (hipFuncSetAttribute((const void*)mk_fwd, hipFuncAttributeMaxDynamicSharedMemorySize, LDS_BYTES) != hipSuccess) { fprintf(stderr, "kernel_launch: hipFuncSetAttribute failed\n"); grid = -1; return; }
        if (hipOccupancyMaxActiveBlocksPerMultiprocessor(&per_cu, (const void*)mk_fwd, NWAVES * 64, LDS_BYTES) != hipSuccess || per_cu < 1) { fprintf(stderr, "kernel_launch: occupancy query says %d\n", per_cu); (void)hipGetLastError(); per_cu = 1; }
        if (cus < M / 256) { fprintf(stderr, "kernel_launch: needs >= 256 CUs\n"); grid = -1; return; }
        grid = M / 256;
    }
    if (grid < 0) return;
    Args a{};
    for (int i = 0; i < 20; ++i) a.in[i] = (const float*)d_in[i];
    a.out = (float*)d_out; a.ws = (unsigned char*)d_ws;
    void* kargs[] = {&a};
    hipError_t e = hipLaunchCooperativeKernel((const void*)mk_fwd, dim3(grid), dim3(NWAVES * 64), kargs, LDS_BYTES, stream);
    if (e != hipSuccess) fprintf(stderr, "kernel_launch: cooperative launch failed: %s (grid %d)\n", hipGetErrorString(e), grid);
}
```

```cpp
#include <hip/hip_runtime.h>
#include <hip/hip_cooperative_groups.h>
#include <cstdio>
#include <cstdint>
namespace cg = cooperative_groups;
namespace pg8 {
#define PG8_LAS __attribute__((address_space(3)))
typedef unsigned short bf16_t;
typedef short bf16x8 __attribute__((ext_vector_type(8)));
typedef float f32x4 __attribute__((ext_vector_type(4)));
typedef unsigned u32x4 __attribute__((ext_vector_type(4)));
constexpr int BM = 256, BK = 64, HALF = 128, HTB = HALF * BK * 2  , STAGE_BYTES = 8 * HTB, NXCD = 8, WGM = 8;

__host__ __device__ __forceinline__ int lds_byte(int r, int c) { const int st = (r >> 4) * 2 + (c >> 5), rr = r & 15, cc = c & 31, ob = rr * 64 + cc * 2; return st * 1024 + (ob ^ (((ob >> 9) & 1) << 5)); }
__host__ __device__ __forceinline__ void stage_rc(int b, int& R, int& C) { const int st = b / 1024, sb = b % 1024, swz = sb ^ (((sb >> 9) & 1) << 5); R = (st >> 1) * 16 + swz / 64; C = (st & 1) * 32 + (swz % 64) / 2; }
__host__ __device__ __forceinline__ int perm32(int rho) { const int n = rho >> 4, i = rho & 15; return 8 * (i >> 2) + 4 * n + (i & 3); }

struct Unit { int pm, pn; };
struct Gemm { const bf16_t* A; const bf16_t* Bt; int M, N, K; };

struct StaticOrder {
    int nM, nN, nwg, G, c;
    __host__ __device__ void init(int M, int N, int G_, int c_) { nM = M / BM; nN = N / BM; nwg = nM * nN; G = G_; c = c_; }
    __host__ __device__ bool next(int i, Unit& u) const {
        const long L = (long)i * G + c; if (L >= nwg) return false;
        int wgid = (int)L; { const int q = nwg / NXCD, r = nwg % NXCD, xcd = wgid % NXCD, off = wgid / NXCD; wgid = (xcd < r ? xcd * (q + 1) : r * (q + 1) + (xcd - r) * q) + off; }
        const int nig = WGM * nN, gid = wgid / nig, fm = gid * WGM, gsz = (nM - fm) < WGM ? (nM - fm) : WGM;
        u.pm = fm + ((wgid % nig) % gsz); u.pn = (wgid % nig) / gsz; return true;
    }
    __device__ __forceinline__ void a_ready(const Unit&) const {}
    __device__ __forceinline__ void done(const Unit&) const {}
};

__device__ __forceinline__ unsigned cvt_pk_bf16(float lo, float hi) { unsigned r; asm volatile("v_cvt_pk_bf16_f32 %0, %1, %2" : "=v"(r) : "v"(lo), "v"(hi)); return r; }
template <int ACT  > struct EpiBf16 {
    static constexpr bool PERM = true, AFTER_DRAIN = false; static_assert(ACT == 0 || ACT == 2, "EpiBf16: ACT is 0 (none) or 2 (relu squared)");
    bf16_t* O; int ldc; const float* bias; int split_cols; size_t split_stride; float scale0;
    __device__ __forceinline__ void operator()(const f32x4 (&acc)[2][2][4][2], const Unit& u, int wr, int wc, int fr, int fq) const {
        const int row0 = u.pm * BM + wr * 64 + fr; int colt = u.pn * BM; bf16_t* base = O;
        float sc = 1.f; if (split_cols) { const int t = colt / split_cols; base += (size_t)t * split_stride; colt -= t * split_cols; if (t == 0) sc = scale0; }
        const int col0 = colt + wc * 32 + 8 * fq, bcol0 = u.pn * BM + wc * 32 + 8 * fq;
        f32x4 bv[2][2];
#pragma unroll
        for (int bj = 0; bj < 2; ++bj)
#pragma unroll
            for (int n = 0; n < 2; ++n) bv[bj][n] = bias ? *(const f32x4*)(bias + bcol0 + bj * HALF + 4 * n) : (f32x4){0.f, 0.f, 0.f, 0.f};
#pragma unroll
        for (int ai = 0; ai < 2; ++ai)
#pragma unroll
            for (int m = 0; m < 4; ++m) { bf16_t* rowp = base + (size_t)(row0 + ai * HALF + m * 16) * ldc + col0;
#pragma unroll
                for (int bj = 0; bj < 2; ++bj) { f32x4 v0 = acc[ai][bj][m][0] + bv[bj][0], v1 = acc[ai][bj][m][1] + bv[bj][1];
                    if (ACT == 2) { v0 = __builtin_elementwise_max(v0, (f32x4){0.f, 0.f, 0.f, 0.f}); v1 = __builtin_elementwise_max(v1, (f32x4){0.f, 0.f, 0.f, 0.f}); v0 = v0 * v0; v1 = v1 * v1; }
                    v0 = v0 * sc; v1 = v1 * sc; u32x4 w; w.x = cvt_pk_bf16(v0[0], v0[1]); w.y = cvt_pk_bf16(v0[2], v0[3]); w.z = cvt_pk_bf16(v1[0], v1[1]); w.w = cvt_pk_bf16(v1[2], v1[3]);
                    *(u32x4*)(rowp + bj * HALF) = w; } }
    }
};
struct EpiResF32 {
    static constexpr bool PERM = false, AFTER_DRAIN = false;
    const float* base; float* out; int ldc;
    __device__ __forceinline__ void operator()(const f32x4 (&acc)[2][2][4][2], const Unit& u, int wr, int wc, int fr, int fq) const {
        const int col0 = u.pn * BM + wc * 32 + 4 * fq;
#pragma unroll
        for (int ai = 0; ai < 2; ++ai)
#pragma unroll
            for (int m = 0; m < 4; ++m) { const int r = ai * HALF + wr * 64 + m * 16 + fr; const size_t off = (size_t)(u.pm * BM + r) * ldc + col0;
#pragma unroll
                for (int bj = 0; bj < 2; ++bj)
#pragma unroll
                    for (int n = 0; n < 2; ++n) { const f32x4 bs = *(const f32x4*)(base + off + bj * HALF + n * 16); const f32x4 o = bs + acc[ai][bj][m][n]; *(f32x4*)(out + off + bj * HALF + n * 16) = o; }
                if (m & 1) asm volatile("" ::: "memory"); }
    }
};
struct PanelOrder {
    int pm, nN;
    __device__ __forceinline__ bool next(int i, Unit& u) const { if (i >= nN) return false; u.pm = pm; u.pn = i; return true; }
    __device__ __forceinline__ void a_ready(const Unit&) const {}
    __device__ __forceinline__ void done(const Unit&) const {}
};
struct TeamOrder {
    int pm0, pstride, pn0, np, nt;
    __device__ __forceinline__ bool next(int i, Unit& u) const { if (i >= np * nt) return false; u.pm = pm0 + (i / nt) * pstride; u.pn = pn0 + (i % nt); return true; }
    __device__ __forceinline__ void a_ready(const Unit&) const {}
    __device__ __forceinline__ void done(const Unit&) const {}
};
template <class Epi, class Sched, bool ALIGN_EPI = false, bool SP2 = false>
__device__ __forceinline__ void gemm_phase(PG8_LAS unsigned char* lds, const Gemm g, const Sched& S, const Epi& E) {
    int tid_ = threadIdx.x; asm volatile("" : "+v"(tid_));
    const int tid = tid_, wid = __builtin_amdgcn_readfirstlane(tid >> 6), lane = tid & 63, wr = wid >> 2, wc = wid & 3, fr = lane & 15, fq = lane >> 4;
    const int K = g.K, nt = K / BK;
    unsigned voffA[2], voffB[2];
#pragma unroll
    for (int i = 0; i < 2; ++i) { int R, C; stage_rc(tid * 16 + i * 8192, R, C); const int Rb = Epi::PERM ? ((R & ~31) + perm32(R & 31)) : R;
        voffA[i] = (unsigned)(R * K + C) * 2u; voffB[i] = (unsigned)(Rb * K + C) * 2u; }
    const size_t kstep = (size_t)(BK * 2);
    const size_t hstep = (size_t)HALF * K * 2;
    const size_t tstep = 2 * hstep;
    const unsigned ldsw = (unsigned)wid * 1024u;
    const int aoff = lds_byte(wr * 64 + fr, fq * 8), boff = lds_byte(wc * 32 + fr, fq * 8);
#define PG8_SA(b, h) (((b) * 2 + (h)) * HTB)
#define PG8_SB(b, h) ((4 + (b) * 2 + (h)) * HTB)
#define PG8_STAGE(bufoff, gbase, voff) do { _Pragma("unroll") for (int _i = 0; _i < 2; ++_i) \
        __builtin_amdgcn_global_load_lds((const unsigned*)((const char*)(gbase) + (voff)[_i]), (PG8_LAS unsigned*)(lds + (bufoff) + ldsw + _i * 8192), 16, 0, 0); } while (0)
#define PG8_LDA(dst, b, h) do { _Pragma("unroll") for (int m = 0; m < 4; ++m) _Pragma("unroll") for (int k = 0; k < 2; ++k) dst[m][k] = *(const PG8_LAS bf16x8*)(lds + PG8_SA(b, h) + aoff + m * 2048 + k * 1024); } while (0)
#define PG8_LDB(dst, b, h) do { _Pragma("unroll") for (int n = 0; n < 2; ++n) _Pragma("unroll") for (int k = 0; k < 2; ++k) dst[n][k] = *(const PG8_LAS bf16x8*)(lds + PG8_SB(b, h) + boff + n * 2048 + k * 1024); } while (0)
#define PG8_MMA(ai, bj, At, Bt) do { __builtin_amdgcn_s_setprio(1); _Pragma("unroll") for (int m = 0; m < 4; ++m) _Pragma("unroll") for (int n = 0; n < 2; ++n) _Pragma("unroll") for (int k = 0; k < 2; ++k) \
        acc[ai][bj][m][n] = __builtin_amdgcn_mfma_f32_16x16x32_bf16(Bt[n][k], At[m][k], acc[ai][bj][m][n], 0, 0, 0); __builtin_amdgcn_s_setprio(0); } while (0)
#define PG8_WAIT_V(n) asm volatile("s_waitcnt vmcnt(" #n ")" ::: "memory")
#define PG8_WAIT_L(n) asm volatile("s_waitcnt lgkmcnt(" #n ")" ::: "memory")
#define PG8_BAR __builtin_amdgcn_s_barrier()
#define PG8_SCHED __builtin_amdgcn_sched_barrier(0)
    Unit cur, nxt; int ui = 0;
    if (!S.next(0, cur)) return;
    f32x4 acc[2][2][4][2];
#pragma unroll
    for (int a = 0; a < 2; ++a)
#pragma unroll
        for (int b = 0; b < 2; ++b)
#pragma unroll
            for (int m = 0; m < 4; ++m)
#pragma unroll
                for (int n = 0; n < 2; ++n) acc[a][b][m][n] = (f32x4){0.f, 0.f, 0.f, 0.f};
    bf16x8 At[4][2], B0[2][2], B1[2][2];
    const char* cA = (const char*)g.A + (size_t)cur.pm * tstep; const char* cB = (const char*)g.Bt + (size_t)cur.pn * tstep;
    S.a_ready(cur);
    if constexpr (SP2) {
        PG8_STAGE(PG8_SB(0, 0), cB, voffB); PG8_STAGE(PG8_SB(0, 1), cB + hstep, voffB); PG8_STAGE(PG8_SA(0, 0), cA, voffA); PG8_STAGE(PG8_SA(0, 1), cA + hstep, voffA);
        if (wr == 1) PG8_BAR;
        PG8_WAIT_V(2); PG8_BAR;
        PG8_STAGE(PG8_SB(1, 0), cB + kstep, voffB); PG8_STAGE(PG8_SA(1, 0), cA + kstep, voffA); PG8_STAGE(PG8_SB(1, 1), cB + hstep + kstep, voffB);
        PG8_WAIT_V(6); PG8_BAR;
    } else {
        PG8_STAGE(PG8_SB(0, 0), cB, voffB); PG8_STAGE(PG8_SA(0, 0), cA, voffA); PG8_STAGE(PG8_SB(0, 1), cB + hstep, voffB); PG8_STAGE(PG8_SA(0, 1), cA + hstep, voffA);
        if (wr == 1) PG8_BAR;
        PG8_WAIT_V(4); PG8_BAR;
        PG8_STAGE(PG8_SB(1, 0), cB + kstep, voffB); PG8_STAGE(PG8_SA(1, 0), cA + kstep, voffA); PG8_STAGE(PG8_SB(1, 1), cB + hstep + kstep, voffB);
        PG8_WAIT_V(6); PG8_BAR;
    }
    for (;;) {
        const bool has_next = S.next(ui + 1, nxt);
        const char* nA = has_next ? (const char*)g.A + (size_t)nxt.pm * tstep : cA; const char* nB = has_next ? (const char*)g.Bt + (size_t)nxt.pn * tstep : cB;
#pragma nounroll
        for (int t = 0; t < nt; t += 2) {
            const bool last = (t == nt - 2);
            const char* a1 = cA + (size_t)(t + 1) * kstep;
            const char* a2 = last ? nA : cA + (size_t)(t + 2) * kstep; const char* b2 = last ? nB : cB + (size_t)(t + 2) * kstep;
            const char* a3 = a2 + kstep; const char* b3 = b2 + kstep;
            if (last && has_next) S.a_ready(nxt);
            if constexpr (SP2) {
            PG8_LDB(B0, 0, 0); PG8_LDB(B1, 0, 1); PG8_SCHED; PG8_LDA(At, 0, 0); PG8_STAGE(PG8_SA(1, 1), a1 + hstep, voffA);
            PG8_WAIT_V(8); PG8_WAIT_L(0); PG8_BAR; PG8_MMA(0, 0, At, B0); PG8_MMA(0, 1, At, B1); PG8_BAR; PG8_SCHED;
            PG8_LDA(At, 0, 1); PG8_STAGE(PG8_SB(0, 0), b2, voffB); PG8_STAGE(PG8_SB(0, 1), b2 + hstep, voffB); PG8_STAGE(PG8_SA(0, 0), a2, voffA);
            PG8_WAIT_V(8); PG8_WAIT_L(0); PG8_BAR; PG8_MMA(1, 0, At, B0); PG8_MMA(1, 1, At, B1); PG8_BAR; PG8_SCHED;
            PG8_LDB(B0, 1, 0); PG8_LDB(B1, 1, 1); PG8_SCHED; PG8_LDA(At, 1, 0); PG8_STAGE(PG8_SA(0, 1), a2 + hstep, voffA);
            PG8_WAIT_V(8); PG8_WAIT_L(0); PG8_BAR; PG8_MMA(0, 0, At, B0); PG8_MMA(0, 1, At, B1); PG8_BAR; PG8_SCHED;
            PG8_LDA(At, 1, 1); PG8_STAGE(PG8_SB(1, 0), b3, voffB); PG8_STAGE(PG8_SB(1, 1), b3 + hstep, voffB); PG8_STAGE(PG8_SA(1, 0), a3, voffA);
            PG8_WAIT_V(8); PG8_WAIT_L(0); PG8_BAR; PG8_MMA(1, 0, At, B0); PG8_MMA(1, 1, At, B1); PG8_BAR; PG8_SCHED;
            } else {
            PG8_LDB(B0, 0, 0); PG8_SCHED; PG8_LDA(At, 0, 0); PG8_STAGE(PG8_SA(1, 1), a1 + hstep, voffA);
            PG8_WAIT_L(8); PG8_BAR; PG8_WAIT_L(0); PG8_MMA(0, 0, At, B0); PG8_BAR; PG8_SCHED;
            PG8_LDB(B1, 0, 1); PG8_STAGE(PG8_SB(0, 0), b2, voffB);
            PG8_BAR; PG8_WAIT_L(0); PG8_MMA(0, 1, At, B1); PG8_BAR;
            PG8_LDA(At, 0, 1); PG8_STAGE(PG8_SA(0, 0), a2, voffA);
            PG8_BAR; PG8_WAIT_L(0); PG8_MMA(1, 0, At, B0); PG8_BAR; PG8_SCHED;
            PG8_STAGE(PG8_SB(0, 1), b2 + hstep, voffB);
            PG8_WAIT_V(6); PG8_BAR; PG8_MMA(1, 1, At, B1); PG8_BAR;
            PG8_LDB(B0, 1, 0); PG8_SCHED; PG8_LDA(At, 1, 0); PG8_STAGE(PG8_SA(0, 1), a2 + hstep, voffA);
            PG8_WAIT_L(8); PG8_BAR; PG8_WAIT_L(0); PG8_MMA(0, 0, At, B0); PG8_BAR; PG8_SCHED;
            PG8_LDB(B1, 1, 1); PG8_STAGE(PG8_SB(1, 0), b3, voffB);
            PG8_BAR; PG8_WAIT_L(0); PG8_MMA(0, 1, At, B1); PG8_BAR;
            PG8_LDA(At, 1, 1); PG8_STAGE(PG8_SA(1, 0), a3, voffA);
            PG8_BAR; PG8_WAIT_L(0); PG8_MMA(1, 0, At, B0); PG8_BAR; PG8_SCHED;
            PG8_STAGE(PG8_SB(1, 1), b3 + hstep, voffB);
            PG8_WAIT_V(6); PG8_BAR; PG8_MMA(1, 1, At, B1); PG8_BAR;
            }
        }
        if constexpr (ALIGN_EPI) { if (wr == 0) PG8_BAR; }
        if constexpr (!Epi::AFTER_DRAIN) { E(acc, cur, wr, wc, fr, fq); S.done(cur); }
        if (!has_next) break;
#pragma unroll
        for (int a = 0; a < 2; ++a)
#pragma unroll
            for (int b = 0; b < 2; ++b)
#pragma unroll
                for (int m = 0; m < 4; ++m)
#pragma unroll
                    for (int n = 0; n < 2; ++n) acc[a][b][m][n] = (f32x4){0.f, 0.f, 0.f, 0.f};
        cur = nxt; cA = nA; cB = nB; ++ui;
        if constexpr (ALIGN_EPI) { if (wr == 1) PG8_BAR; }
    }
    PG8_WAIT_V(0);
    if constexpr (!ALIGN_EPI) { if (wr == 0) PG8_BAR; }
    PG8_BAR;
    if constexpr (Epi::AFTER_DRAIN) { E.fused(acc, cur, wr, wc, fr, fq, lds, wid, lane); S.done(cur); }
#undef PG8_SA
#undef PG8_SB
#undef PG8_STAGE
#undef PG8_LDA
#undef PG8_LDB
#undef PG8_MMA
#undef PG8_WAIT_V
#undef PG8_WAIT_L
#undef PG8_BAR
#undef PG8_SCHED
}
}
#ifndef REP_SCAN
#define REP_SCAN 1
#endif
#ifndef REP_ATTN
#define REP_ATTN 1
#endif
#ifndef REP_HELP
#define REP_HELP 1
#endif
#ifndef REP_P4
#define REP_P4 1
#endif
#ifndef REP_P1
#define REP_P1 1
#endif
#ifndef REP_P2
#define REP_P2 1
#endif
#ifndef REP_CHAIN
#define REP_CHAIN 1
#endif
#ifndef PG8_SP2
#define PG8_SP2 true
#endif
#ifndef PG8_ALIGN
#define PG8_ALIGN true
#endif
constexpr int NWAVES = 8;
constexpr int BATCH = 16, T = 4096, D = 1024, M = BATCH * T;
constexpr int INW = 2560, FF = 4096, NLORA = 1536, KLORA = 256;
constexpr int ZR0 = 768;
constexpr float RMS_EPS = 1e-6f, GN_EPS = 64e-5f;
constexpr size_t MiB = 1u << 20;
constexpr size_t WS_WIN = 2 * MiB, WS_WOUT = 8 * MiB, WS_WUP = 10 * MiB, WS_WDOWN = 18 * MiB, WS_BL = 26 * MiB;
constexpr size_t WS_MIX = 32 * MiB, WS_XN = 160 * MiB, WS_Z = 288 * MiB, WS_ALORA = 608 * MiB, WS_LORA = 640 * MiB, WS_H = 288 * MiB, WS_PB = 832 * MiB, WS_QB = 896 * MiB, WS_END = 960 * MiB;
constexpr int LDS_BYTES = 147456;

#define GAS __attribute__((address_space(1)))
#define LAS __attribute__((address_space(3)))
typedef unsigned short bf16;
typedef unsigned v4u __attribute__((ext_vector_type(4)));
typedef unsigned v2u __attribute__((ext_vector_type(2)));
typedef float f32x4 __attribute__((ext_vector_type(4)));
typedef float f32x2 __attribute__((ext_vector_type(2)));
typedef float f32x16 __attribute__((ext_vector_type(16)));
typedef short bf16x8 __attribute__((ext_vector_type(8)));
typedef short s16x4 __attribute__((ext_vector_type(4)));
#define LDS_WAIT() asm volatile("s_waitcnt lgkmcnt(0)" ::: "memory")
#define VM_WAIT() asm volatile("s_waitcnt vmcnt(0)" ::: "memory")
typedef __bf16 bf16x2_t __attribute__((ext_vector_type(2)));
__device__ __forceinline__ unsigned f2bf(float f) { return (unsigned)__builtin_bit_cast(unsigned short, (__bf16)f); }
__device__ __forceinline__ unsigned pk2(float lo, float hi) { const bf16x2_t v = __builtin_convertvector((f32x2){lo, hi}, bf16x2_t); return __builtin_bit_cast(unsigned, v); }
__device__ __forceinline__ float bf2f(unsigned short b) { return __builtin_bit_cast(float, (unsigned)b << 16); }
__device__ __forceinline__ float bflo(unsigned w) { return __builtin_bit_cast(float, w << 16); }
__device__ __forceinline__ float bfhi(unsigned w) { return __builtin_bit_cast(float, w & 0xffff0000u); }
__device__ __forceinline__ float wave_sum(float v) {
#pragma unroll
    for (int o = 1; o < 64; o <<= 1) v += __shfl_xor(v, o);
    return v;
}
template <int CTRL, int RM = 0xF> __device__ __forceinline__ float dppf(float v) { return __builtin_bit_cast(float, __builtin_amdgcn_update_dpp(0, __builtin_bit_cast(int, v), CTRL, RM, 0xF, true)); }
__device__ __forceinline__ float red16(float v) { v += dppf<0xB1>(v); v += dppf<0x4E>(v); v += dppf<0x141>(v); v += dppf<0x140>(v); return v; }
__device__ __forceinline__ float red4(float v) { v += dppf<0xB1>(v); v += dppf<0x4E>(v); return v; }
__device__ __forceinline__ float red8(float v) { v += dppf<0xB1>(v); v += dppf<0x4E>(v); v += dppf<0x141>(v); return v; }
__device__ __forceinline__ float wsum(float v) {
    v += dppf<0xB1>(v); v += dppf<0x4E>(v); v += dppf<0x141>(v); v += dppf<0x140>(v);
    v += dppf<0x142, 0xA>(v); v += dppf<0x143, 0xC>(v);
    return __builtin_bit_cast(float, __builtin_amdgcn_readlane(__builtin_bit_cast(int, v), 63));
}
__device__ __forceinline__ float sigmoidf_(float x) { return __builtin_amdgcn_rcpf(1.0f + __expf(-x)); }
#define WG_BAR_LDS() do { asm volatile("s_waitcnt lgkmcnt(0)" ::: "memory"); __builtin_amdgcn_s_barrier(); asm volatile("" ::: "memory"); } while (0)
__device__ __forceinline__ void wg_global_sync() { VM_WAIT(); __syncthreads(); __builtin_amdgcn_fence(__ATOMIC_ACQUIRE, "agent"); VM_WAIT(); }

struct Args { const float* in[20]; float* out; unsigned char* ws; };
#define RLX_AGENT __ATOMIC_RELAXED, __HIP_MEMORY_SCOPE_AGENT
#define XB_TMO      128
#define XB_XCNT(j)  (256  + 64 * (j))
#define XB_XSUB(j)  (1280 + 64 * (j))
#define XB_XGEN(j)  (2304 + 64 * (j))
#define XB_TOP      3328
#define XB_TOPGEN   3392
#define XCD_BAR_WORDS 3456
#define XB_SPIN_CAP (1u << 18)

__device__ __forceinline__ unsigned xb_ld(unsigned* p)              { return __hip_atomic_load(p, __ATOMIC_RELAXED, __HIP_MEMORY_SCOPE_AGENT); }
__device__ __forceinline__ unsigned xb_add(unsigned* p, unsigned v) { return __hip_atomic_fetch_add(p, v, __ATOMIC_RELAXED, __HIP_MEMORY_SCOPE_AGENT); }
__device__ __forceinline__ unsigned xb_xcc_id() { return (unsigned)__builtin_amdgcn_s_getreg((3 << 11) | 20) & 0xFu; }
#define XB_SPIN(cond, bar) do { unsigned _sp = 0; while (cond) { __builtin_amdgcn_s_sleep(1); \
    if ((++_sp & 255u) == 0u) { if (xb_ld(&(bar)[XB_TMO])) break; if (_sp > XB_SPIN_CAP) { atomicAdd(&(bar)[XB_TMO], 1u); break; } } } } while (0)

struct XcdBarrier {
    unsigned* bar; unsigned x;
    volatile LAS unsigned* st;
};

__device__ __forceinline__ XcdBarrier xcd_barrier_post(unsigned* bar, volatile LAS unsigned* st) {
    XcdBarrier b; b.bar = bar; b.x = xb_xcc_id(); b.st = st;
    if (threadIdx.x == 0) (void)xb_add(&bar[XB_XCNT(b.x)], 1u);
    return b;
}
__device__ __forceinline__ void xcd_barrier_complete(unsigned* bar, unsigned x, unsigned& nloc, unsigned& nx) {
    const unsigned G = gridDim.x * gridDim.y * gridDim.z;
    unsigned sum, cnt, mine, sp = 0u;
    for (;;) {
        sum = 0u; cnt = 0u; mine = 0u;
#pragma unroll
        for (unsigned j = 0; j < 16; ++j) { const unsigned c = xb_ld(&bar[XB_XCNT(j)]); sum += c; cnt += (c > 0u) ? 1u : 0u; mine = (j == x) ? c : mine; }
        if (sum == G) break;
        __builtin_amdgcn_s_sleep(1);
        if ((++sp & 255u) == 0u) { if (xb_ld(&bar[XB_TMO])) break; if (sp > XB_SPIN_CAP) { atomicAdd(&bar[XB_TMO], 1u); break; } }
    }
    nloc = mine > 0u ? mine : 1u; nx = cnt > 0u ? cnt : 1u;
}

__device__ __forceinline__ void xcd_barrier(const XcdBarrier& b) {
    asm volatile("s_waitcnt vmcnt(0)" ::: "memory");
    __syncthreads();
    if (threadIdx.x == 0) {
        unsigned* bar = b.bar;
        __builtin_amdgcn_s_waitcnt(0);
        unsigned nloc = b.st[0], nx = b.st[1];
        if (nloc == 0u) { xcd_barrier_complete(bar, b.x, nloc, nx); b.st[0] = nloc; b.st[1] = nx; }
        const unsigned old = xb_add(&bar[XB_XSUB(b.x)], 1u);
        const unsigned gen = old / nloc;
        if (old + 1u == (gen + 1u) * nloc) {
            __builtin_amdgcn_fence(__ATOMIC_RELEASE, "agent");
            asm volatile("s_waitcnt vmcnt(0)" ::: "memory");
            const unsigned og = xb_add(&bar[XB_TOP], 1u);
            const unsigned tg = og / nx;
            if (og + 1u == (tg + 1u) * nx) xb_add(&bar[XB_TOPGEN], 1u);
            else XB_SPIN(xb_ld(&bar[XB_TOPGEN]) == tg, bar);
            __builtin_amdgcn_fence(__ATOMIC_ACQUIRE, "agent");
            xb_add(&bar[XB_XGEN(b.x)], 1u);
            asm volatile("s_waitcnt vmcnt(0)" ::: "memory");
        } else {
            XB_SPIN(xb_ld(&bar[XB_XGEN(b.x)]) == gen, bar);
            __builtin_amdgcn_fence(__ATOMIC_ACQUIRE, "agent");
            asm volatile("s_waitcnt vmcnt(0)" ::: "memory");
        }
    }
    __syncthreads();
}

__device__ __forceinline__ void team_barrier(unsigned* cnt, unsigned np) {
    VM_WAIT(); __syncthreads();
    if (threadIdx.x == 0) {
        __builtin_amdgcn_fence(__ATOMIC_RELEASE, "agent"); VM_WAIT();
        __hip_atomic_fetch_add(cnt, 1u, __ATOMIC_RELAXED, __HIP_MEMORY_SCOPE_AGENT);
        unsigned sp = 0;
        while (__hip_atomic_load(cnt, __ATOMIC_RELAXED, __HIP_MEMORY_SCOPE_AGENT) < np) { __builtin_amdgcn_s_sleep(2); if (++sp > (1u << 22)) break; }
        __builtin_amdgcn_fence(__ATOMIC_ACQUIRE, "agent"); VM_WAIT();
    }
    __syncthreads();
}
__device__ __forceinline__ void p0_transpose_item(const float* W, int K, int N, bf16* WT, LAS float* scr, int item, int lane) {
    const int nblk = N / 32, kb = item / nblk, nb = item % nblk, k0 = 64 * kb, n0 = 32 * nb;
#pragma unroll 8
    for (int i = 0; i < 32; ++i) { const int kk = 2 * i + (lane >> 5); scr[kk * 33 + (lane & 31)] = W[(size_t)(k0 + kk) * N + n0 + (lane & 31)]; }
    LDS_WAIT(); asm volatile("" ::: "memory");
    const int c = lane & 7;
#pragma unroll
    for (int j = 0; j < 4; ++j) { const int n = (lane >> 3) + 8 * j; const LAS float* s = scr + (8 * c) * 33 + n;
        v4u o; o.x = pk2(s[0 * 33], s[1 * 33]); o.y = pk2(s[2 * 33], s[3 * 33]); o.z = pk2(s[4 * 33], s[5 * 33]); o.w = pk2(s[6 * 33], s[7 * 33]);
        *(GAS v4u*)(WT + (size_t)(n0 + n) * K + k0 + 8 * c) = o; }
    LDS_WAIT(); asm volatile("" ::: "memory");
}
template <int NR> __device__ __forceinline__ void rms_rows_to_bf16(const float* x0, size_t xstride, const float* g, bf16* o0, size_t ostride, int lane) {
    const GAS f32x4* gr = (const GAS f32x4*)g + lane;
    f32x4 v[NR][4]; float s[NR];
#pragma unroll
    for (int r = 0; r < NR; ++r) { const GAS f32x4* xr = (const GAS f32x4*)(x0 + r * xstride) + lane;
#pragma unroll
        for (int j = 0; j < 4; ++j) v[r][j] = xr[64 * j]; }
#pragma unroll
    for (int r = 0; r < NR; ++r) { float a = 0.f;
#pragma unroll
        for (int j = 0; j < 4; ++j) a += (v[r][j].x * v[r][j].x + v[r][j].y * v[r][j].y) + (v[r][j].z * v[r][j].z + v[r][j].w * v[r][j].w);
        s[r] = a; }
#pragma unroll
    for (int r = 0; r < NR; ++r) { const float rstd = __builtin_amdgcn_rsqf(wsum(s[r]) * (1.f / D) + RMS_EPS);
        GAS unsigned long long* o8 = (GAS unsigned long long*)(o0 + r * ostride) + lane;
#pragma unroll
        for (int j = 0; j < 4; ++j) { const f32x4 gg = gr[64 * j]; o8[64 * j] = (unsigned long long)pk2(v[r][j].x * rstd * gg.x, v[r][j].y * rstd * gg.y) | ((unsigned long long)pk2(v[r][j].z * rstd * gg.z, v[r][j].w * rstd * gg.w) << 32); } }
}
template <int NR> __device__ __forceinline__ void rms_rows_inplace(float* x0, size_t xstride, const float* g, int lane) {
    const GAS f32x4* gr = (const GAS f32x4*)g + lane;
    f32x4 v[NR][4]; float s[NR];
#pragma unroll
    for (int r = 0; r < NR; ++r) { const GAS f32x4* xr = (const GAS f32x4*)(x0 + r * xstride) + lane;
#pragma unroll
        for (int j = 0; j < 4; ++j) v[r][j] = xr[64 * j]; }
#pragma unroll
    for (int r = 0; r < NR; ++r) { float a = 0.f;
#pragma unroll
        for (int j = 0; j < 4; ++j) a += (v[r][j].x * v[r][j].x + v[r][j].y * v[r][j].y) + (v[r][j].z * v[r][j].z + v[r][j].w * v[r][j].w);
        s[r] = a; }
#pragma unroll
    for (int r = 0; r < NR; ++r) { const float rstd = __builtin_amdgcn_rsqf(wsum(s[r]) * (1.f / D) + RMS_EPS);
        GAS f32x4* xr = (GAS f32x4*)(x0 + r * xstride) + lane;
#pragma unroll
        for (int j = 0; j < 4; ++j) { const f32x4 gg = gr[64 * j]; xr[64 * j] = v[r][j] * rstd * gg; } }
}

__device__ __forceinline__ void lora_in_row(const bf16* Z, const float* mu, bf16* AL, int m, int lane) {
    const int c = 4 * lane;
    const v2u zc = *(const GAS v2u*)(Z + (size_t)m * INW + 2304 + c);
    const bool hasp = (m % T) != 0;
    const v2u zp = *(const GAS v2u*)(Z + (size_t)(hasp ? m - 1 : m) * INW + 2304 + c);
    const float fac = hasp ? 1.f : 0.f;
    const f32x4 mv = *(const GAS f32x4*)(mu + 1536 + c);
    float z[4] = {bflo(zc.x), bfhi(zc.x), bflo(zc.y), bfhi(zc.y)}, p[4] = {bflo(zp.x) * fac, bfhi(zp.x) * fac, bflo(zp.y) * fac, bfhi(zp.y) * fac}, o[4];
#pragma unroll
    for (int j = 0; j < 4; ++j) { const float v = z[j] + (p[j] - z[j]) * mv[j];
        o[j] = (c < 64) ? (1.f - 2.f / (1.f + __expf(2.f * v))) : ((c < 128) ? v : sigmoidf_(v)); }
    v2u w; w.x = pk2(o[0], o[1]); w.y = pk2(o[2], o[3]);
    *(GAS v2u*)(AL + (size_t)m * KLORA + c) = w;
}

constexpr int AT_KSTR = 144, AT_VSTR = 520, AT_VOFF = 256 * AT_KSTR;
__device__ __forceinline__ int crow(int r, int hi) { return (r & 3) + 8 * (r >> 2) + 4 * hi; }
__device__ __forceinline__ void attn_unit(LAS unsigned char* lds, const bf16* Z, bf16* MIX, const float* sinks, int b, int nb, int kvh) {
    const int tid = threadIdx.x, wid = __builtin_amdgcn_readfirstlane(tid >> 6), lane = tid & 63;
    __syncthreads();
#pragma unroll
    for (int i = 0; i < 4; ++i) {
        const int chunk = tid + 512 * i, key = chunk >> 3, c8 = chunk & 7, kpos = nb * 128 - 128 + key;
        v4u kv = (v4u){0u, 0u, 0u, 0u}, vv = (v4u){0u, 0u, 0u, 0u};
        if (kpos >= 0) { const bf16* zr = Z + (size_t)(b * T + kpos) * INW + 512 + kvh * 64 + c8 * 8; kv = *(const GAS v4u*)zr; vv = *(const GAS v4u*)(zr + 128); }
        *(LAS v4u*)(lds + key * AT_KSTR + c8 * 16) = kv;
        LAS unsigned short* vt = (LAS unsigned short*)(lds + AT_VOFF + (c8 * 8) * AT_VSTR + key * 2);
#pragma unroll
        for (int e = 0; e < 4; ++e) { vt[(2 * e) * (AT_VSTR / 2)] = (unsigned short)(vv[e] & 0xffffu); vt[(2 * e + 1) * (AT_VSTR / 2)] = (unsigned short)(vv[e] >> 16); }
    }
    __syncthreads();
    const int g = wid >> 1, hq = kvh * 4 + g, qhalf = wid & 1, q = lane & 31, hh = lane >> 5;
    const float slope = exp2f(-(float)(hq + 1)), sink = sinks[hq];
    for (int qt = 0; qt < 2; ++qt) {
        const int q0 = qhalf * 64 + qt * 32, qi = q0 + q, kt0 = q0 >> 5; const size_t m = (size_t)b * T + nb * 128 + qi;
        bf16x8 qf[4];
#pragma unroll
        for (int s = 0; s < 4; ++s) qf[s] = *(const GAS bf16x8*)(Z + m * INW + hq * 64 + 16 * s + 8 * hh);
        f32x16 sc[5];
#pragma unroll
        for (int i = 0; i < 5; ++i) {
#pragma unroll
            for (int r = 0; r < 16; ++r) sc[i][r] = 0.f;
#pragma unroll
            for (int s = 0; s < 4; ++s) { const bf16x8 a = *(const LAS bf16x8*)(lds + (32 * (kt0 + i) + q) * AT_KSTR + (16 * s + 8 * hh) * 2); sc[i] = __builtin_amdgcn_mfma_f32_32x32x16_bf16(a, qf[s], sc[i], 0, 0, 0); }
        }
        float mx = -1e30f;
#pragma unroll
        for (int i = 0; i < 5; ++i)
#pragma unroll
            for (int r = 0; r < 16; ++r) { const int kj = 32 * (kt0 + i) + crow(r, hh), dist = qi - kj + 128; const bool valid = (dist >= 0) && (dist < 128) && (nb * 128 - 128 + kj >= 0);
                const float v = valid ? (sc[i][r] * 0.125f - slope * (float)dist) : -1e30f; sc[i][r] = v; mx = fmaxf(mx, v); }
        mx = fmaxf(mx, __shfl_xor(mx, 32)); mx = fmaxf(mx, sink);
        float sum = 0.f;
#pragma unroll
        for (int i = 0; i < 5; ++i)
#pragma unroll
            for (int r = 0; r < 16; ++r) { const float e = __expf(sc[i][r] - mx); sc[i][r] = e; sum += e; }
        sum += __shfl_xor(sum, 32);
        const float inv = 1.0f / (sum + __expf(sink - mx));
        f32x16 o[2];
#pragma unroll
        for (int r = 0; r < 16; ++r) { o[0][r] = 0.f; o[1][r] = 0.f; }
#pragma unroll
        for (int i = 0; i < 5; ++i)
#pragma unroll
            for (int s = 0; s < 2; ++s) {
                v4u pw;
#pragma unroll
                for (int j = 0; j < 4; ++j) pw[j] = pk2(sc[i][8 * s + 2 * j] * inv, sc[i][8 * s + 2 * j + 1] * inv);
                const bf16x8 xs = __builtin_bit_cast(bf16x8, pw);
                const int kb = 32 * (kt0 + i) + 16 * s + 4 * hh;
#pragma unroll
                for (int dt = 0; dt < 2; ++dt) { const LAS unsigned char* vp = lds + AT_VOFF + (dt * 32 + q) * AT_VSTR + kb * 2;
                    const s16x4 lo = *(const LAS s16x4*)vp, hi = *(const LAS s16x4*)(vp + 16);
                    const bf16x8 pa = __builtin_shufflevector(lo, hi, 0, 1, 2, 3, 4, 5, 6, 7);
                    o[dt] = __builtin_amdgcn_mfma_f32_32x32x16_bf16(pa, xs, o[dt], 0, 0, 0); }
            }
        bf16* orow = MIX + m * D + hq * 64 + 4 * hh;
#pragma unroll
        for (int dt = 0; dt < 2; ++dt)
#pragma unroll
            for (int r4 = 0; r4 < 4; ++r4) { v2u w; w.x = pk2(o[dt][4 * r4], o[dt][4 * r4 + 1]); w.y = pk2(o[dt][4 * r4 + 2], o[dt][4 * r4 + 3]); *(GAS v2u*)(orow + dt * 32 + 8 * r4) = w; }
    }
}

constexpr int TC = 16, NCH = T / TC;
constexpr int SC_W = 0, SC_A = TC * 64, SC_B = 2 * TC * 64, SC_K = 3 * TC * 64, SC_R = 4 * TC * 64, SC_V = 5 * TC * 64, SC_G = 6 * TC * 64, SC_BON = 7 * TC * 64, SC_YP = 7 * TC * 64 + 64, SC_BUF = SC_YP + TC * 32 * 4;
static_assert(2 * SC_BUF * 4 <= 131072, "scan LDS");
struct ScanConst { f32x4 mu_r, mu_k, mu_v, w0, a0, kk, ka, rk; };
struct ScanRaw { v2u zr[3], zp[3], lo[3]; float fac; };
__device__ __forceinline__ f32x4 unpack4(v2u p) { return (f32x4){bflo(p.x), bfhi(p.x), bflo(p.y), bfhi(p.y)}; }
__device__ __forceinline__ float sum4(f32x4 v) { return (v.x + v.y) + (v.z + v.w); }
__device__ __forceinline__ void scan_load(ScanRaw& R, const bf16* Z, const bf16* LORA, int b, int h, int t0, int k4, int lane) {
    const int t = 4 * k4 + (lane >> 4), hc = h * 64 + 4 * (lane & 15); const size_t m = (size_t)b * T + t0 + t; const bool hasp = (t0 + t) > 0; R.fac = hasp ? 1.f : 0.f;
    const bf16* zrow = Z + m * INW + ZR0 + hc; const bf16* prow = hasp ? zrow - INW : zrow; const bf16* lrow = LORA + m * NLORA + hc;
#pragma unroll
    for (int j = 0; j < 3; ++j) { R.zr[j] = *(const GAS v2u*)(zrow + 512 * j); R.zp[j] = *(const GAS v2u*)(prow + 512 * j); R.lo[j] = *(const GAS v2u*)(lrow + 512 * j); }
}
__device__ __forceinline__ void scan_store(LAS float* buf, const ScanRaw& R, int k4, int lane, const ScanConst& c) {
    const int t = 4 * k4 + (lane >> 4), cg = lane & 15;
    const f32x4 zr = unpack4(R.zr[0]), zk = unpack4(R.zr[1]), zv = unpack4(R.zr[2]);
    const f32x4 xr = zr + (unpack4(R.zp[0]) * R.fac - zr) * c.mu_r, xk = zk + (unpack4(R.zp[1]) * R.fac - zk) * c.mu_k, xv = zv + (unpack4(R.zp[2]) * R.fac - zv) * c.mu_v;
    const f32x4 lw = unpack4(R.lo[0]) + c.w0, la = unpack4(R.lo[1]) + c.a0, g = unpack4(R.lo[2]);
    f32x4 w, a;
#pragma unroll
    for (int e = 0; e < 4; ++e) { w[e] = __expf(-0.60653066f * sigmoidf_(lw[e])); a[e] = sigmoidf_(la[e]); }
    const f32x4 kkr = xk * c.kk; const float ss = red16(sum4(kkr * kkr)); const f32x4 kk = kkr * __builtin_amdgcn_rsqf(fmaxf(ss, 1e-24f));
    const f32x4 k = xk * (1.f + (a - 1.f) * c.ka);
    const float bon = red16(sum4(xr * k * c.rk));
    *(LAS f32x4*)(buf + SC_W + t * 64 + 4 * cg) = w; *(LAS f32x4*)(buf + SC_A + t * 64 + 4 * cg) = -kk; *(LAS f32x4*)(buf + SC_B + t * 64 + 4 * cg) = kk * a; *(LAS f32x4*)(buf + SC_K + t * 64 + 4 * cg) = k;
    *(LAS f32x4*)(buf + SC_R + t * 64 + 4 * cg) = xr; *(LAS f32x4*)(buf + SC_V + t * 64 + 4 * cg) = xv; *(LAS f32x4*)(buf + SC_G + t * 64 + 4 * cg) = g; if (cg == 0) buf[SC_BON + t] = bon;
}
__device__ __forceinline__ void scan_output(const LAS float* buf, float* Y, bf16* PB, bf16* QB, int b, int h, int half, int t0, int k4, int lane, f32x2 lnw2, f32x2 lnb2) {
    const int t = 4 * k4 + (lane >> 4), cg = lane & 15, row = half * 32 + 2 * cg; const size_t m = (size_t)b * T + t0 + t;
    const LAS f32x4* yp = (const LAS f32x4*)(buf + SC_YP + (t * 32 + 2 * cg) * 4);
    f32x2 y; y.x = sum4(yp[0]); y.y = sum4(yp[1]);
    const f32x2 v = *(const LAS f32x2*)(buf + SC_V + t * 64 + row), g = *(const LAS f32x2*)(buf + SC_G + t * 64 + row);
    const float bon = buf[SC_BON + t];
    const f32x2 P = g * lnw2, Q = (lnb2 + v * bon) * g;
    const size_t off = m * 512 + h * 64 + row;
    *(GAS f32x2*)(Y + off) = y; *(GAS unsigned*)(PB + off) = pk2(P.x, P.y); *(GAS unsigned*)(QB + off) = pk2(Q.x, Q.y);
}
struct ScanOps { f32x4 a, w, b, k, r; float v0, v1; };
__device__ __forceinline__ void scan_ops_load(ScanOps& o, const LAS float* buf, int t, int slice, int vrow) {
    o.a = *(const LAS f32x4*)(buf + SC_A + t * 64 + slice * 4); o.w = *(const LAS f32x4*)(buf + SC_W + t * 64 + slice * 4); o.b = *(const LAS f32x4*)(buf + SC_B + t * 64 + slice * 4);
    o.k = *(const LAS f32x4*)(buf + SC_K + t * 64 + slice * 4); o.r = *(const LAS f32x4*)(buf + SC_R + t * 64 + slice * 4);
    o.v0 = buf[SC_V + t * 64 + vrow]; o.v1 = buf[SC_V + t * 64 + vrow + 16];
}
__device__ __forceinline__ void scan_steps(LAS float* buf, f32x2 (&S0)[2], f32x2 (&S1)[2], int slice, int rq, int vrow) {
    ScanOps cur; scan_ops_load(cur, buf, 0, slice, vrow);
    float yp0 = 0.f, yp1 = 0.f;
#pragma unroll
    for (int t = 0; t < TC; ++t) {
        ScanOps nxt; if (t + 1 < TC) scan_ops_load(nxt, buf, t + 1, slice, vrow);
        __builtin_amdgcn_sched_barrier(0);
        const f32x2 a[2] = {cur.a.xy, cur.a.zw}, w[2] = {cur.w.xy, cur.w.zw}, bb[2] = {cur.b.xy, cur.b.zw}, k[2] = {cur.k.xy, cur.k.zw}, r[2] = {cur.r.xy, cur.r.zw};
        const f32x2 d0 = S0[0] * a[0] + S0[1] * a[1], d1 = S1[0] * a[0] + S1[1] * a[1];
        float e0 = d0.x + d0.y, e1 = d1.x + d1.y;
        e0 += dppf<0xB1>(e0); e1 += dppf<0xB1>(e1); yp0 += dppf<0xB1>(yp0); yp1 += dppf<0xB1>(yp1);
        e0 += dppf<0x4E>(e0); e1 += dppf<0x4E>(e1); yp0 += dppf<0x4E>(yp0); yp1 += dppf<0x4E>(yp1);
        e0 += dppf<0x141>(e0); e1 += dppf<0x141>(e1);
        if (t > 0) { buf[SC_YP + ((t - 1) * 32 + rq) * 4 + (slice >> 2)] = yp0; buf[SC_YP + ((t - 1) * 32 + rq + 16) * 4 + (slice >> 2)] = yp1; }
        e0 += dppf<0x140>(e0); e1 += dppf<0x140>(e1);
        const f32x2 sa0v = {e0, e0}, sa1v = {e1, e1}, v0v = {cur.v0, cur.v0}, v1v = {cur.v1, cur.v1};
#pragma unroll
        for (int q = 0; q < 2; ++q) { S0[q] = S0[q] * w[q] + (sa0v * bb[q] + v0v * k[q]); S1[q] = S1[q] * w[q] + (sa1v * bb[q] + v1v * k[q]); }
        const f32x2 y0 = S0[0] * r[0] + S0[1] * r[1], y1 = S1[0] * r[0] + S1[1] * r[1];
        yp0 = y0.x + y0.y; yp1 = y1.x + y1.y;
        __builtin_amdgcn_sched_barrier(0);
        if (t + 1 < TC) cur = nxt;
    }
    yp0 = red4(yp0); yp1 = red4(yp1);
    buf[SC_YP + ((TC - 1) * 32 + rq) * 4 + (slice >> 2)] = yp0; buf[SC_YP + ((TC - 1) * 32 + rq + 16) * 4 + (slice >> 2)] = yp1;
}
__device__ __forceinline__ void scan_unit(LAS float* lds, const bf16* Z, const bf16* LORA, float* Y, bf16* PB, bf16* QB, const Args& args, int b, int h, int half) {
    const int tid = threadIdx.x, wid = __builtin_amdgcn_readfirstlane(tid >> 6), lane = tid & 63;
    __syncthreads();
    if (wid < 4) {
        const int slice = tid & 15, rq = tid >> 4, vrow = half * 32 + rq;
        f32x2 S0[2], S1[2];
#pragma unroll
        for (int q = 0; q < 2; ++q) { S0[q] = (f32x2){0.f, 0.f}; S1[q] = (f32x2){0.f, 0.f}; }
        WG_BAR_LDS();
        for (int ch = 0; ch < NCH; ++ch) { scan_steps(lds + (ch & 1) * SC_BUF, S0, S1, slice, rq, vrow); WG_BAR_LDS(); }
    } else {
        const int k4 = wid - 4, hc4 = h * 64 + 4 * (lane & 15), row = h * 64 + half * 32 + 2 * (lane & 15);
        ScanConst c; c.mu_r = *(const GAS f32x4*)(args.in[4] + hc4); c.mu_k = *(const GAS f32x4*)(args.in[4] + 512 + hc4); c.mu_v = *(const GAS f32x4*)(args.in[4] + 1024 + hc4); c.w0 = *(const GAS f32x4*)(args.in[5] + hc4); c.a0 = *(const GAS f32x4*)(args.in[7] + hc4);
        c.kk = *(const GAS f32x4*)(args.in[10] + hc4); c.ka = *(const GAS f32x4*)(args.in[11] + hc4); c.rk = *(const GAS f32x4*)(args.in[12] + hc4);
        const f32x2 lnw2 = *(const GAS f32x2*)(args.in[13] + row), lnb2 = *(const GAS f32x2*)(args.in[14] + row);
        ScanRaw Re, Ro; scan_load(Re, Z, LORA, b, h, 0, k4, lane); scan_store(lds, Re, k4, lane, c); scan_load(Ro, Z, LORA, b, h, TC, k4, lane); scan_load(Re, Z, LORA, b, h, 2 * TC, k4, lane);
        WG_BAR_LDS();
        for (int ch = 0; ch < NCH; ch += 2) {
            {
                LAS float* oth = lds + SC_BUF;
                if (ch > 0) scan_output(oth, Y, PB, QB, b, h, half, (ch - 1) * TC, k4, lane, lnw2, lnb2);
                scan_store(oth, Ro, k4, lane, c);
                if (ch + 3 < NCH) scan_load(Ro, Z, LORA, b, h, (ch + 3) * TC, k4, lane);
                WG_BAR_LDS();
            }
            {
                LAS float* oth = lds;
                scan_output(oth, Y, PB, QB, b, h, half, ch * TC, k4, lane, lnw2, lnb2);
                if (ch + 2 < NCH) { scan_store(oth, Re, k4, lane, c); if (ch + 4 < NCH) scan_load(Re, Z, LORA, b, h, (ch + 4) * TC, k4, lane); }
                WG_BAR_LDS();
            }
        }
        scan_output(lds + ((NCH - 1) & 1) * SC_BUF, Y, PB, QB, b, h, half, (NCH - 1) * TC, k4, lane, lnw2, lnb2);
    }
    __syncthreads();
}
__device__ __forceinline__ void rwkv_post_panel(const float* Y, const bf16* PB, const bf16* QB, bf16* MIX, int pm, int wave, int lane) {
    const int tsub = lane >> 4, cg = lane & 15;
    for (int j0 = 0; j0 < 64; j0 += 4) {
        f32x4 y[4]; v2u p[4], q[4];
#pragma unroll
        for (int u = 0; u < 4; ++u) { const size_t off = (size_t)(pm * 256 + (j0 + u) * 4 + tsub) * 512 + wave * 64 + 4 * cg; y[u] = *(const GAS f32x4*)(Y + off); p[u] = *(const GAS v2u*)(PB + off); q[u] = *(const GAS v2u*)(QB + off); }
#pragma unroll
        for (int u = 0; u < 4; ++u) { const size_t m = (size_t)(pm * 256 + (j0 + u) * 4 + tsub);
            const float mean = red16(sum4(y[u])) * (1.f / 64.f); const f32x4 d = y[u] - mean; const float var = red16(sum4(d * d)) * (1.f / 64.f);
            const f32x4 o = d * __builtin_amdgcn_rsqf(var + GN_EPS) * unpack4(p[u]) + unpack4(q[u]);
            v2u pw; pw.x = pk2(o[0], o[1]); pw.y = pk2(o[2], o[3]);
            *(GAS v2u*)(MIX + m * D + 512 + wave * 64 + 4 * cg) = pw; }
    }
}

__global__ void __launch_bounds__(NWAVES * 64, 2) mk_fwd(Args args) {
    extern __shared__ __attribute__((aligned(16))) unsigned char lds_raw[];
    LAS unsigned char* lds = (LAS unsigned char*)lds_raw;
    cg::grid_group grid = cg::this_grid();
    volatile LAS unsigned* bar_st = (volatile LAS unsigned*)(lds + 131072 + 64);
    if (threadIdx.x == 0) { bar_st[0] = 0u; bar_st[1] = 0u; }
    __syncthreads();
    const int tid = threadIdx.x, lane = tid & 63, wave = __builtin_amdgcn_readfirstlane(tid >> 6);
    const int G = gridDim.x, bx = blockIdx.x;
    unsigned char* ws = args.ws;
    const float* x = args.in[0]; float* out = args.out;
    bf16* WIN = (bf16*)(ws + WS_WIN); bf16* WOUT = (bf16*)(ws + WS_WOUT); bf16* WUP = (bf16*)(ws + WS_WUP); bf16* WDOWN = (bf16*)(ws + WS_WDOWN); bf16* BL = (bf16*)(ws + WS_BL);
    bf16* MIX = (bf16*)(ws + WS_MIX); float* Yb = (float*)(ws + WS_XN); bf16* PB = (bf16*)(ws + WS_PB); bf16* QB = (bf16*)(ws + WS_QB); bf16* XN = (bf16*)(ws + WS_XN); bf16* Zb = (bf16*)(ws + WS_Z); bf16* AL = (bf16*)(ws + WS_ALORA); bf16* LORA = (bf16*)(ws + WS_LORA); bf16* HB = (bf16*)(ws + WS_H);

    {
        LAS float* scr = (LAS float*)(lds + wave * 16384);
        const int gw = bx * NWAVES + wave, NGW = G * NWAVES;
        constexpr int I_IN = (D / 64) * (INW / 32), I_OUT = (D / 64) * (D / 32), I_UP = (D / 64) * (FF / 32), I_DN = (FF / 64) * (D / 32);
        constexpr int NITEMS = I_IN + I_OUT + I_UP + I_DN;
        for (int it = gw; it < NITEMS; it += NGW) {
            int r = it;
            if (r < I_IN) { p0_transpose_item(args.in[2], D, INW, WIN, scr, r, lane); continue; } r -= I_IN;
            if (r < I_OUT) { p0_transpose_item(args.in[15], D, D, WOUT, scr, r, lane); continue; } r -= I_OUT;
            if (r < I_UP) { p0_transpose_item(args.in[17], D, FF, WUP, scr, r, lane); continue; } r -= I_UP;
            p0_transpose_item(args.in[18], FF, D, WDOWN, scr, r, lane);
        }
        if (bx == 0) for (int i = tid; i < 32768; i += NWAVES * 64) ((unsigned*)ws)[i] = 0u;
        for (int idx = bx * (NWAVES * 64) + tid; idx < NLORA * KLORA; idx += G * NWAVES * 64) {
            const int n = idx / KLORA, k = idx % KLORA; float v = 0.f;
            if (n < 512) { if (k < 64) v = args.in[6][k * 512 + n]; }
            else if (n < 1024) { if (k >= 64 && k < 128) v = args.in[8][(k - 64) * 512 + (n - 512)]; }
            else { if (k >= 128) v = args.in[9][(k - 128) * 512 + (n - 1024)]; }
            BL[idx] = (bf16)f2bf(v);
        }
        for (int m = gw * 4; m < M; m += NGW * 4) rms_rows_to_bf16<4>(x + (size_t)m * D, D, args.in[1], XN + (size_t)m * D, D, lane);
    }
    grid.sync();
    const XcdBarrier xbar = xcd_barrier_post((unsigned*)ws + 16384, bar_st);
    for (int rep_ = 0; rep_ < REP_P1; ++rep_) {
        pg8::Gemm g{XN, WIN, M, INW, D}; pg8::StaticOrder S; S.init(M, INW, G, bx);
        pg8::EpiBf16<0> E{Zb, INW, nullptr, 0, 0, 1.f};
#ifndef NO_P1
        pg8::gemm_phase<pg8::EpiBf16<0>, pg8::StaticOrder, PG8_ALIGN, PG8_SP2>(lds, g, S, E);
#endif
    }
    xcd_barrier(xbar);
    if (bx < M / 256) { const int pm = bx;
        for (int r = wave * 4; r < 256; r += NWAVES * 4) {
#pragma unroll
            for (int q = 0; q < 4; ++q) lora_in_row(Zb, args.in[4], AL, pm * 256 + r + q, lane); }
        wg_global_sync();
        pg8::Gemm g{AL, BL, M, NLORA, KLORA}; pg8::PanelOrder S{pm, NLORA / 256};
        pg8::EpiBf16<0> E{LORA, NLORA, nullptr, 0, 0, 1.f};
#ifndef NO_P1B
        pg8::gemm_phase<pg8::EpiBf16<0>, pg8::PanelOrder, PG8_ALIGN, PG8_SP2>(lds, g, S, E);
#endif
    }
    xcd_barrier(xbar);
    {
        for (int u = bx; u < BATCH * 32 * 2; u += G) attn_unit(lds, Zb, MIX, args.in[3], u >> 6, (u >> 1) & 31, u & 1);
        for (int u = bx; u < BATCH * 16; u += G) scan_unit((LAS float*)lds, Zb, LORA, Yb, PB, QB, args, u >> 4, (u >> 1) & 7, u & 1);
    }
    xcd_barrier(xbar);
    if (bx < M / 256) { const int pm = bx;
        const int xq = bx & 7, role = (bx >> 3) & 3, q = bx >> 5, tp0 = q * 32 + xq; unsigned* tcnt = (unsigned*)ws + (size_t)(q * 8 + xq) * 256;
        rwkv_post_panel(Yb, PB, QB, MIX, pm, wave, lane);
        team_barrier(tcnt, 4u);
        { pg8::Gemm g{MIX, WOUT, M, D, D}; pg8::TeamOrder S{tp0, 8, role, 4, 1}; pg8::EpiResF32 E{x, out, D};
          pg8::gemm_phase<pg8::EpiResF32, pg8::TeamOrder, PG8_ALIGN, PG8_SP2>(lds, g, S, E); }
        team_barrier(tcnt + 32, 4u);
        for (int r = wave * 4; r < 256; r += NWAVES * 4) rms_rows_to_bf16<4>(out + (size_t)(pm * 256 + r) * D, D, args.in[16], XN + (size_t)(pm * 256 + r) * D, D, lane);
        team_barrier(tcnt + 64, 4u);
        { pg8::Gemm g{XN, WUP, M, FF, D}; pg8::TeamOrder S{tp0, 8, role * 4, 4, 4}; pg8::EpiBf16<2> E{HB, FF, nullptr, 0, 0, 1.f};
          pg8::gemm_phase<pg8::EpiBf16<2>, pg8::TeamOrder, PG8_ALIGN, PG8_SP2>(lds, g, S, E); }
        team_barrier(tcnt + 96, 4u);
        { pg8::Gemm g{HB, WDOWN, M, D, FF}; pg8::TeamOrder S{tp0, 8, role, 4, 1}; pg8::EpiResF32 E{out, out, D};
          pg8::gemm_phase<pg8::EpiResF32, pg8::TeamOrder, PG8_ALIGN, PG8_SP2>(lds, g, S, E); }
        team_barrier(tcnt + 128, 4u);
        for (int r = wave * 4; r < 256; r += NWAVES * 4) rms_rows_inplace<4>(out + (size_t)(pm * 256 + r) * D, D, args.in[19], lane);
    }
}

extern "C" void kernel_launch(void* const* d_in, const int* in_sizes, int n_in, void* d_out, int out_size, void* d_ws, size_t ws_size, hipStream_t stream) {
    static int grid = 0;
    if (grid == 0) {
        if (n_in != 20 || in_sizes[0] != M * D || out_size != M * D || ws_size < WS_END) { fprintf(stderr, "kernel_launch: unexpected shapes (n_in %d, in0 %d, out %d, ws %zu)\n", n_in, n_in > 0 ? in_sizes[0] : -1, out_size, ws_size); grid = -1; return; }
        int dev = 0, cus = 0, per_cu = 0;
        if (hipGetDevice(&dev) != hipSuccess || hipDeviceGetAttribute(&cus, hipDeviceAttributeMultiprocessorCount, dev) != hipSuccess) { grid = -1; return; }
        if (hipFuncSetAttribute((const void*)mk_fwd, hipFuncAttributeMaxDynamicSharedMemorySize, LDS_BYTES) != hipSuccess) { fprintf(stderr, "kernel_launch: hipFuncSetAttribute failed\n"); grid = -1; return; }
        if (hipOccupancyMaxActiveBlocksPerMultiprocessor(&per_cu, (const void*)mk_fwd, NWAVES * 64, LDS_BYTES) != hipSuccess || per_cu < 1) { fprintf(stderr, "kernel_launch: occupancy query says %d\n", per_cu); (void)hipGetLastError(); per_cu = 1; }
        if (cus < M / 256) { fprintf(stderr, "kernel_launch: needs >= 256 CUs\n"); grid = -1; return; }
        grid = M / 256;
    }
    if (grid < 0) return;
    Args a{};
    for (int i = 0; i < 20; ++i) a.in[i] = (const float*)d_in[i];
    a.out = (float*)d_out; a.ws = (unsigned char*)d_ws;
    void* kargs[] = {&a};
    hipError_t e = hipLaunchCooperativeKernel((const void*)mk_fwd, dim3(grid), dim3(NWAVES * 64), kargs, LDS_BYTES, stream);
    if (e != hipSuccess) fprintf(stderr, "kernel_launch: cooperative launch failed: %s (grid %d)\n", hipGetErrorString(e), grid);
}
```

```cpp
#include <hip/hip_runtime.h>
#include <hip/hip_cooperative_groups.h>
#include <cstdio>
#include <cstdint>
namespace cg = cooperative_groups;
namespace pg8 {
#define PG8_LAS __attribute__((address_space(3)))
typedef unsigned short bf16_t;
typedef short bf16x8 __attribute__((ext_vector_type(8)));
typedef float f32x4 __attribute__((ext_vector_type(4)));
typedef unsigned u32x4 __attribute__((ext_vector_type(4)));
constexpr int BM = 256, BK = 64, HALF = 128, HTB = HALF * BK * 2  , STAGE_BYTES = 8 * HTB, NXCD = 8, WGM = 8;

__host__ __device__ __forceinline__ int lds_byte(int r, int c) { const int st = (r >> 4) * 2 + (c >> 5), rr = r & 15, cc = c & 31, ob = rr * 64 + cc * 2; return st * 1024 + (ob ^ (((ob >> 9) & 1) << 5)); }
__host__ __device__ __forceinline__ void stage_rc(int b, int& R, int& C) { const int st = b / 1024, sb = b % 1024, swz = sb ^ (((sb >> 9) & 1) << 5); R = (st >> 1) * 16 + swz / 64; C = (st & 1) * 32 + (swz % 64) / 2; }
__host__ __device__ __forceinline__ int perm32(int rho) { const int n = rho >> 4, i = rho & 15; return 8 * (i >> 2) + 4 * n + (i & 3); }

struct Unit { int pm, pn; };
struct Gemm { const bf16_t* A; const bf16_t* Bt; int M, N, K; };

struct StaticOrder {
    int nM, nN, nwg, G, c;
    __host__ __device__ void init(int M, int N, int G_, int c_) { nM = M / BM; nN = N / BM; nwg = nM * nN; G = G_; c = c_; }
    __host__ __device__ bool next(int i, Unit& u) const {
        const long L = (long)i * G + c; if (L >= nwg) return false;
        int wgid = (int)L; { const int q = nwg / NXCD, r = nwg % NXCD, xcd = wgid % NXCD, off = wgid / NXCD; wgid = (xcd < r ? xcd * (q + 1) : r * (q + 1) + (xcd - r) * q) + off; }
        const int nig = WGM * nN, gid = wgid / nig, fm = gid * WGM, gsz = (nM - fm) < WGM ? (nM - fm) : WGM;
        u.pm = fm + ((wgid % nig) % gsz); u.pn = (wgid % nig) / gsz; return true;
    }
    __device__ __forceinline__ void a_ready(const Unit&) const {}
    __device__ __forceinline__ void done(const Unit&) const {}
};

__device__ __forceinline__ unsigned cvt_pk_bf16(float lo, float hi) { unsigned r; asm volatile("v_cvt_pk_bf16_f32 %0, %1, %2" : "=v"(r) : "v"(lo), "v"(hi)); return r; }
template <int ACT  > struct EpiBf16 {
    static constexpr bool PERM = true, AFTER_DRAIN = false; static_assert(ACT == 0 || ACT == 2, "EpiBf16: ACT is 0 (none) or 2 (relu squared)");
    bf16_t* O; int ldc; const float* bias; int split_cols; size_t split_stride; float scale0;
    __device__ __forceinline__ void operator()(const f32x4 (&acc)[2][2][4][2], const Unit& u, int wr, int wc, int fr, int fq) const {
        const int row0 = u.pm * BM + wr * 64 + fr; int colt = u.pn * BM; bf16_t* base = O;
        float sc = 1.f; if (split_cols) { const int t = colt / split_cols; base += (size_t)t * split_stride; colt -= t * split_cols; if (t == 0) sc = scale0; }
        const int col0 = colt + wc * 32 + 8 * fq, bcol0 = u.pn * BM + wc * 32 + 8 * fq;
        f32x4 bv[2][2];
#pragma unroll
        for (int bj = 0; bj < 2; ++bj)
#pragma unroll
            for (int n = 0; n < 2; ++n) bv[bj][n] = bias ? *(const f32x4*)(bias + bcol0 + bj * HALF + 4 * n) : (f32x4){0.f, 0.f, 0.f, 0.f};
#pragma unroll
        for (int ai = 0; ai < 2; ++ai)
#pragma unroll
            for (int m = 0; m < 4; ++m) { bf16_t* rowp = base + (size_t)(row0 + ai * HALF + m * 16) * ldc + col0;
#pragma unroll
                for (int bj = 0; bj < 2; ++bj) { f32x4 v0 = acc[ai][bj][m][0] + bv[bj][0], v1 = acc[ai][bj][m][1] + bv[bj][1];
                    if (ACT == 2) { v0 = __builtin_elementwise_max(v0, (f32x4){0.f, 0.f, 0.f, 0.f}); v1 = __builtin_elementwise_max(v1, (f32x4){0.f, 0.f, 0.f, 0.f}); v0 = v0 * v0; v1 = v1 * v1; }
                    v0 = v0 * sc; v1 = v1 * sc; u32x4 w; w.x = cvt_pk_bf16(v0[0], v0[1]); w.y = cvt_pk_bf16(v0[2], v0[3]); w.z = cvt_pk_bf16(v1[0], v1[1]); w.w = cvt_pk_bf16(v1[2], v1[3]);
                    *(u32x4*)(rowp + bj * HALF) = w; } }
    }
};
struct EpiResF32 {
    static constexpr bool PERM = false, AFTER_DRAIN = false;
    const float* base; float* out; int ldc;
    __device__ __forceinline__ void operator()(const f32x4 (&acc)[2][2][4][2], const Unit& u, int wr, int wc, int fr, int fq) const {
        const int col0 = u.pn * BM + wc * 32 + 4 * fq;
#pragma unroll
        for (int ai = 0; ai < 2; ++ai)
#pragma unroll
            for (int m = 0; m < 4; ++m) { const int r = ai * HALF + wr * 64 + m * 16 + fr; const size_t off = (size_t)(u.pm * BM + r) * ldc + col0;
#pragma unroll
                for (int bj = 0; bj < 2; ++bj)
#pragma unroll
                    for (int n = 0; n < 2; ++n) { const f32x4 bs = *(const f32x4*)(base + off + bj * HALF + n * 16); const f32x4 o = bs + acc[ai][bj][m][n]; *(f32x4*)(out + off + bj * HALF + n * 16) = o; }
                if (m & 1) asm volatile("" ::: "memory"); }
    }
};
struct PanelOrder {
    int pm, nN;
    __device__ __forceinline__ bool next(int i, Unit& u) const { if (i >= nN) return false; u.pm = pm; u.pn = i; return true; }
    __device__ __forceinline__ void a_ready(const Unit&) const {}
    __device__ __forceinline__ void done(const Unit&) const {}
};
struct TeamOrder {
    int pm0, pstride, pn0, np, nt;
    __device__ __forceinline__ bool next(int i, Unit& u) const { if (i >= np * nt) return false; u.pm = pm0 + (i / nt) * pstride; u.pn = pn0 + (i % nt); return true; }
    __device__ __forceinline__ void a_ready(const Unit&) const {}
    __device__ __forceinline__ void done(const Unit&) const {}
};
template <class Epi, class Sched, bool ALIGN_EPI = false, bool SP2 = false>
__device__ __forceinline__ void gemm_phase(PG8_LAS unsigned char* lds, const Gemm g, const Sched& S, const Epi& E) {
    int tid_ = threadIdx.x; asm volatile("" : "+v"(tid_));
    const int tid = tid_, wid = __builtin_amdgcn_readfirstlane(tid >> 6), lane = tid & 63, wr = wid >> 2, wc = wid & 3, fr = lane & 15, fq = lane >> 4;
    const int K = g.K, nt = K / BK;
    unsigned voffA[2], voffB[2];
#pragma unroll
    for (int i = 0; i < 2; ++i) { int R, C; stage_rc(tid * 16 + i * 8192, R, C); const int Rb = Epi::PERM ? ((R & ~31) + perm32(R & 31)) : R;
        voffA[i] = (unsigned)(R * K + C) * 2u; voffB[i] = (unsigned)(Rb * K + C) * 2u; }
    const size_t kstep = (size_t)(BK * 2);
    const size_t hstep = (size_t)HALF * K * 2;
    const size_t tstep = 2 * hstep;
    const unsigned ldsw = (unsigned)wid * 1024u;
    const int aoff = lds_byte(wr * 64 + fr, fq * 8), boff = lds_byte(wc * 32 + fr, fq * 8);
#define PG8_SA(b, h) (((b) * 2 + (h)) * HTB)
#define PG8_SB(b, h) ((4 + (b) * 2 + (h)) * HTB)
#define PG8_STAGE(bufoff, gbase, voff) do { _Pragma("unroll") for (int _i = 0; _i < 2; ++_i) \
        __builtin_amdgcn_global_load_lds((const unsigned*)((const char*)(gbase) + (voff)[_i]), (PG8_LAS unsigned*)(lds + (bufoff) + ldsw + _i * 8192), 16, 0, 0); } while (0)
#define PG8_LDA(dst, b, h) do { _Pragma("unroll") for (int m = 0; m < 4; ++m) _Pragma("unroll") for (int k = 0; k < 2; ++k) dst[m][k] = *(const PG8_LAS bf16x8*)(lds + PG8_SA(b, h) + aoff + m * 2048 + k * 1024); } while (0)
#define PG8_LDB(dst, b, h) do { _Pragma("unroll") for (int n = 0; n < 2; ++n) _Pragma("unroll") for (int k = 0; k < 2; ++k) dst[n][k] = *(const PG8_LAS bf16x8*)(lds + PG8_SB(b, h) + boff + n * 2048 + k * 1024); } while (0)
#define PG8_MMA(ai, bj, At, Bt) do { __builtin_amdgcn_s_setprio(1); _Pragma("unroll") for (int m = 0; m < 4; ++m) _Pragma("unroll") for (int n = 0; n < 2; ++n) _Pragma("unroll") for (int k = 0; k < 2; ++k) \
        acc[ai][bj][m][n] = __builtin_amdgcn_mfma_f32_16x16x32_bf16(Bt[n][k], At[m][k], acc[ai][bj][m][n], 0, 0, 0); __builtin_amdgcn_s_setprio(0); } while (0)
#define PG8_WAIT_V(n) asm volatile("s_waitcnt vmcnt(" #n ")" ::: "memory")
#define PG8_WAIT_L(n) asm volatile("s_waitcnt lgkmcnt(" #n ")" ::: "memory")
#define PG8_BAR __builtin_amdgcn_s_barrier()
#define PG8_SCHED __builtin_amdgcn_sched_barrier(0)
    Unit cur, nxt; int ui = 0;
    if (!S.next(0, cur)) return;
    f32x4 acc[2][2][4][2];
#pragma unroll
    for (int a = 0; a < 2; ++a)
#pragma unroll
        for (int b = 0; b < 2; ++b)
#pragma unroll
            for (int m = 0; m < 4; ++m)
#pragma unroll
                for (int n = 0; n < 2; ++n) acc[a][b][m][n] = (f32x4){0.f, 0.f, 0.f, 0.f};
    bf16x8 At[4][2], B0[2][2], B1[2][2];
    const char* cA = (const char*)g.A + (size_t)cur.pm * tstep; const char* cB = (const char*)g.Bt + (size_t)cur.pn * tstep;
    S.a_ready(cur);
    if constexpr (SP2) {
        PG8_STAGE(PG8_SB(0, 0), cB, voffB); PG8_STAGE(PG8_SB(0, 1), cB + hstep, voffB); PG8_STAGE(PG8_SA(0, 0), cA, voffA); PG8_STAGE(PG8_SA(0, 1), cA + hstep, voffA);
        if (wr == 1) PG8_BAR;
        PG8_WAIT_V(2); PG8_BAR;
        PG8_STAGE(PG8_SB(1, 0), cB + kstep, voffB); PG8_STAGE(PG8_SA(1, 0), cA + kstep, voffA); PG8_STAGE(PG8_SB(1, 1), cB + hstep + kstep, voffB);
        PG8_WAIT_V(6); PG8_BAR;
    } else {
        PG8_STAGE(PG8_SB(0, 0), cB, voffB); PG8_STAGE(PG8_SA(0, 0), cA, voffA); PG8_STAGE(PG8_SB(0, 1), cB + hstep, voffB); PG8_STAGE(PG8_SA(0, 1), cA + hstep, voffA);
        if (wr == 1) PG8_BAR;
        PG8_WAIT_V(4); PG8_BAR;
        PG8_STAGE(PG8_SB(1, 0), cB + kstep, voffB); PG8_STAGE(PG8_SA(1, 0), cA + kstep, voffA); PG8_STAGE(PG8_SB(1, 1), cB + hstep + kstep, voffB);
        PG8_WAIT_V(6); PG8_BAR;
    }
    for (;;) {
        const bool has_next = S.next(ui + 1, nxt);
        const char* nA = has_next ? (const char*)g.A + (size_t)nxt.pm * tstep : cA; const char* nB = has_next ? (const char*)g.Bt + (size_t)nxt.pn * tstep : cB;
#pragma nounroll
        for (int t = 0; t < nt; t += 2) {
            const bool last = (t == nt - 2);
            const char* a1 = cA + (size_t)(t + 1) * kstep;
            const char* a2 = last ? nA : cA + (size_t)(t + 2) * kstep; const char* b2 = last ? nB : cB + (size_t)(t + 2) * kstep;
            const char* a3 = a2 + kstep; const char* b3 = b2 + kstep;
            if (last && has_next) S.a_ready(nxt);
            if constexpr (SP2) {
            PG8_LDB(B0, 0, 0); PG8_LDB(B1, 0, 1); PG8_SCHED; PG8_LDA(At, 0, 0); PG8_STAGE(PG8_SA(1, 1), a1 + hstep, voffA);
            PG8_WAIT_V(8); PG8_WAIT_L(0); PG8_BAR; PG8_MMA(0, 0, At, B0); PG8_MMA(0, 1, At, B1); PG8_BAR; PG8_SCHED;
            PG8_LDA(At, 0, 1); PG8_STAGE(PG8_SB(0, 0), b2, voffB); PG8_STAGE(PG8_SB(0, 1), b2 + hstep, voffB); PG8_STAGE(PG8_SA(0, 0), a2, voffA);
            PG8_WAIT_V(8); PG8_WAIT_L(0); PG8_BAR; PG8_MMA(1, 0, At, B0); PG8_MMA(1, 1, At, B1); PG8_BAR; PG8_SCHED;
            PG8_LDB(B0, 1, 0); PG8_LDB(B1, 1, 1); PG8_SCHED; PG8_LDA(At, 1, 0); PG8_STAGE(PG8_SA(0, 1), a2 + hstep, voffA);
            PG8_WAIT_V(8); PG8_WAIT_L(0); PG8_BAR; PG8_MMA(0, 0, At, B0); PG8_MMA(0, 1, At, B1); PG8_BAR; PG8_SCHED;
            PG8_LDA(At, 1, 1); PG8_STAGE(PG8_SB(1, 0), b3, voffB); PG8_STAGE(PG8_SB(1, 1), b3 + hstep, voffB); PG8_STAGE(PG8_SA(1, 0), a3, voffA);
            PG8_WAIT_V(8); PG8_WAIT_L(0); PG8_BAR; PG8_MMA(1, 0, At, B0); PG8_MMA(1, 1, At, B1); PG8_BAR; PG8_SCHED;
            } else {
            PG8_LDB(B0, 0, 0); PG8_SCHED; PG8_LDA(At, 0, 0); PG8_STAGE(PG8_SA(1, 1), a1 + hstep, voffA);
            PG8_WAIT_L(8); PG8_BAR; PG8_WAIT_L(0); PG8_MMA(0, 0, At, B0); PG8_BAR; PG8_SCHED;
            PG8_LDB(B1, 0, 1); PG8_STAGE(PG8_SB(0, 0), b2, voffB);
            PG8_BAR; PG8_WAIT_L(0); PG8_MMA(0, 1, At, B1); PG8_BAR;
            PG8_LDA(At, 0, 1); PG8_STAGE(PG8_SA(0, 0), a2, voffA);
            PG8_BAR; PG8_WAIT_L(0); PG8_MMA(1, 0, At, B0); PG8_BAR; PG8_SCHED;
            PG8_STAGE(PG8_SB(0, 1), b2 + hstep, voffB);
            PG8_WAIT_V(6); PG8_BAR; PG8_MMA(1, 1, At, B1); PG8_BAR;
            PG8_LDB(B0, 1, 0); PG8_SCHED; PG8_LDA(At, 1, 0); PG8_STAGE(PG8_SA(0, 1), a2 + hstep, voffA);
            PG8_WAIT_L(8); PG8_BAR; PG8_WAIT_L(0); PG8_MMA(0, 0, At, B0); PG8_BAR; PG8_SCHED;
            PG8_LDB(B1, 1, 1); PG8_STAGE(PG8_SB(1, 0), b3, voffB);
            PG8_BAR; PG8_WAIT_L(0); PG8_MMA(0, 1, At, B1); PG8_BAR;
            PG8_LDA(At, 1, 1); PG8_STAGE(PG8_SA(1, 0), a3, voffA);
            PG8_BAR; PG8_WAIT_L(0); PG8_MMA(1, 0, At, B0); PG8_BAR; PG8_SCHED;
            PG8_STAGE(PG8_SB(1, 1), b3 + hstep, voffB);
            PG8_WAIT_V(6); PG8_BAR; PG8_MMA(1, 1, At, B1); PG8_BAR;
            }
        }
        if constexpr (ALIGN_EPI) { if (wr == 0) PG8_BAR; }
        if constexpr (!Epi::AFTER_DRAIN) { E(acc, cur, wr, wc, fr, fq); S.done(cur); }
        if (!has_next) break;
#pragma unroll
        for (int a = 0; a < 2; ++a)
#pragma unroll
            for (int b = 0; b < 2; ++b)
#pragma unroll
                for (int m = 0; m < 4; ++m)
#pragma unroll
                    for (int n = 0; n < 2; ++n) acc[a][b][m][n] = (f32x4){0.f, 0.f, 0.f, 0.f};
        cur = nxt; cA = nA; cB = nB; ++ui;
        if constexpr (ALIGN_EPI) { if (wr == 1) PG8_BAR; }
    }
    PG8_WAIT_V(0);
    if constexpr (!ALIGN_EPI) { if (wr == 0) PG8_BAR; }
    PG8_BAR;
    if constexpr (Epi::AFTER_DRAIN) { E.fused(acc, cur, wr, wc, fr, fq, lds, wid, lane); S.done(cur); }
#undef PG8_SA
#undef PG8_SB
#undef PG8_STAGE
#undef PG8_LDA
#undef PG8_LDB
#undef PG8_MMA
#undef PG8_WAIT_V
#undef PG8_WAIT_L
#undef PG8_BAR
#undef PG8_SCHED
}
}
#ifndef REP_SCAN
#define REP_SCAN 1
#endif
#ifndef REP_ATTN
#define REP_ATTN 1
#endif
#ifndef REP_HELP
#define REP_HELP 1
#endif
#ifndef REP_P4
#define REP_P4 1
#endif
#ifndef REP_P1
#define REP_P1 1
#endif
#ifndef REP_P2
#define REP_P2 1
#endif
#ifndef REP_CHAIN
#define REP_CHAIN 1
#endif
#ifndef PG8_SP2
#define PG8_SP2 true
#endif
#ifndef PG8_ALIGN
#define PG8_ALIGN true
#endif
constexpr int NWAVES = 8;
constexpr int BATCH = 16, T = 4096, D = 1024, M = BATCH * T;
constexpr int INW = 2560, FF = 4096, NLORA = 1536, KLORA = 256;
constexpr int ZR0 = 768;
constexpr float RMS_EPS = 1e-6f, GN_EPS = 64e-5f;
constexpr size_t MiB = 1u << 20;
constexpr size_t WS_WIN = 2 * MiB, WS_WOUT = 8 * MiB, WS_WUP = 10 * MiB, WS_WDOWN = 18 * MiB, WS_BL = 26 * MiB;
constexpr size_t WS_MIX = 32 * MiB, WS_XN = 160 * MiB, WS_Z = 288 * MiB, WS_ALORA = 608 * MiB, WS_LORA = 640 * MiB, WS_H = 288 * MiB, WS_PB = 832 * MiB, WS_QB = 896 * MiB, WS_END = 960 * MiB;
constexpr int LDS_BYTES = 147456;

#define GAS __attribute__((address_space(1)))
#define LAS __attribute__((address_space(3)))
typedef unsigned short bf16;
typedef unsigned v4u __attribute__((ext_vector_type(4)));
typedef unsigned v2u __attribute__((ext_vector_type(2)));
typedef float f32x4 __attribute__((ext_vector_type(4)));
typedef float f32x2 __attribute__((ext_vector_type(2)));
typedef float f32x16 __attribute__((ext_vector_type(16)));
typedef short bf16x8 __attribute__((ext_vector_type(8)));
typedef short s16x4 __attribute__((ext_vector_type(4)));
#define LDS_WAIT() asm volatile("s_waitcnt lgkmcnt(0)" ::: "memory")
#define VM_WAIT() asm volatile("s_waitcnt vmcnt(0)" ::: "memory")
typedef __bf16 bf16x2_t __attribute__((ext_vector_type(2)));
__device__ __forceinline__ unsigned f2bf(float f) { return (unsigned)__builtin_bit_cast(unsigned short, (__bf16)f); }
__device__ __forceinline__ unsigned pk2(float lo, float hi) { const bf16x2_t v = __builtin_convertvector((f32x2){lo, hi}, bf16x2_t); return __builtin_bit_cast(unsigned, v); }
__device__ __forceinline__ float bf2f(unsigned short b) { return __builtin_bit_cast(float, (unsigned)b << 16); }
__device__ __forceinline__ float bflo(unsigned w) { return __builtin_bit_cast(float, w << 16); }
__device__ __forceinline__ float bfhi(unsigned w) { return __builtin_bit_cast(float, w & 0xffff0000u); }
__device__ __forceinline__ float wave_sum(float v) {
#pragma unroll
    for (int o = 1; o < 64; o <<= 1) v += __shfl_xor(v, o);
    return v;
}
template <int CTRL, int RM = 0xF> __device__ __forceinline__ float dppf(float v) { return __builtin_bit_cast(float, __builtin_amdgcn_update_dpp(0, __builtin_bit_cast(int, v), CTRL, RM, 0xF, true)); }
__device__ __forceinline__ float red16(float v) { v += dppf<0xB1>(v); v += dppf<0x4E>(v); v += dppf<0x141>(v); v += dppf<0x140>(v); return v; }
__device__ __forceinline__ float red4(float v) { v += dppf<0xB1>(v); v += dppf<0x4E>(v); return v; }
__device__ __forceinline__ float red8(float v) { v += dppf<0xB1>(v); v += dppf<0x4E>(v); v += dppf<0x141>(v); return v; }
__device__ __forceinline__ float wsum(float v) {
    v += dppf<0xB1>(v); v += dppf<0x4E>(v); v += dppf<0x141>(v); v += dppf<0x140>(v);
    v += dppf<0x142, 0xA>(v); v += dppf<0x143, 0xC>(v);
    return __builtin_bit_cast(float, __builtin_amdgcn_readlane(__builtin_bit_cast(int, v), 63));
}
__device__ __forceinline__ float sigmoidf_(float x) { return __builtin_amdgcn_rcpf(1.0f + __expf(-x)); }
#define WG_BAR_LDS() do { asm volatile("s_waitcnt lgkmcnt(0)" ::: "memory"); __builtin_amdgcn_s_barrier(); asm volatile("" ::: "memory"); } while (0)
__device__ __forceinline__ void wg_global_sync() { VM_WAIT(); __syncthreads(); __builtin_amdgcn_fence(__ATOMIC_ACQUIRE, "agent"); VM_WAIT(); }

struct Args { const float* in[20]; float* out; unsigned char* ws; };
#define RLX_AGENT __ATOMIC_RELAXED, __HIP_MEMORY_SCOPE_AGENT
#define XB_TMO      128
#define XB_XCNT(j)  (256  + 64 * (j))
#define XB_XSUB(j)  (1280 + 64 * (j))
#define XB_XGEN(j)  (2304 + 64 * (j))
#define XB_TOP      3328
#define XB_TOPGEN   3392
#define XCD_BAR_WORDS 3456
#define XB_SPIN_CAP (1u << 18)

__device__ __forceinline__ unsigned xb_ld(unsigned* p)              { return __hip_atomic_load(p, __ATOMIC_RELAXED, __HIP_MEMORY_SCOPE_AGENT); }
__device__ __forceinline__ unsigned xb_add(unsigned* p, unsigned v) { return __hip_atomic_fetch_add(p, v, __ATOMIC_RELAXED, __HIP_MEMORY_SCOPE_AGENT); }
__device__ __forceinline__ unsigned xb_xcc_id() { return (unsigned)__builtin_amdgcn_s_getreg((3 << 11) | 20) & 0xFu; }
#define XB_SPIN(cond, bar) do { unsigned _sp = 0; while (cond) { __builtin_amdgcn_s_sleep(1); \
    if ((++_sp & 255u) == 0u) { if (xb_ld(&(bar)[XB_TMO])) break; if (_sp > XB_SPIN_CAP) { atomicAdd(&(bar)[XB_TMO], 1u); break; } } } } while (0)

struct XcdBarrier {
    unsigned* bar; unsigned x;
    volatile LAS unsigned* st;
};

__device__ __forceinline__ XcdBarrier xcd_barrier_post(unsigned* bar, volatile LAS unsigned* st) {
    XcdBarrier b; b.bar = bar; b.x = xb_xcc_id(); b.st = st;
    if (threadIdx.x == 0) (void)xb_add(&bar[XB_XCNT(b.x)], 1u);
    return b;
}
__device__ __forceinline__ void xcd_barrier_complete(unsigned* bar, unsigned x, unsigned& nloc, unsigned& nx) {
    const unsigned G = gridDim.x * gridDim.y * gridDim.z;
    unsigned sum, cnt, mine, sp = 0u;
    for (;;) {
        sum = 0u; cnt = 0u; mine = 0u;
#pragma unroll
        for (unsigned j = 0; j < 16; ++j) { const unsigned c = xb_ld(&bar[XB_XCNT(j)]); sum += c; cnt += (c > 0u) ? 1u : 0u; mine = (j == x) ? c : mine; }
        if (sum == G) break;
        __builtin_amdgcn_s_sleep(1);
        if ((++sp & 255u) == 0u) { if (xb_ld(&bar[XB_TMO])) break; if (sp > XB_SPIN_CAP) { atomicAdd(&bar[XB_TMO], 1u); break; } }
    }
    nloc = mine > 0u ? mine : 1u; nx = cnt > 0u ? cnt : 1u;
}

__device__ __forceinline__ void xcd_barrier(const XcdBarrier& b) {
    asm volatile("s_waitcnt vmcnt(0)" ::: "memory");
    __syncthreads();
    if (threadIdx.x == 0) {
        unsigned* bar = b.bar;
        __builtin_amdgcn_s_waitcnt(0);
        unsigned nloc = b.st[0], nx = b.st[1];
        if (nloc == 0u) { xcd_barrier_complete(bar, b.x, nloc, nx); b.st[0] = nloc; b.st[1] = nx; }
        const unsigned old = xb_add(&bar[XB_XSUB(b.x)], 1u);
        const unsigned gen = old / nloc;
        if (old + 1u == (gen + 1u) * nloc) {
            __builtin_amdgcn_fence(__ATOMIC_RELEASE, "agent");
            asm volatile("s_waitcnt vmcnt(0)" ::: "memory");
            const unsigned og = xb_add(&bar[XB_TOP], 1u);
            const unsigned tg = og / nx;
            if (og + 1u == (tg + 1u) * nx) xb_add(&bar[XB_TOPGEN], 1u);
            else XB_SPIN(xb_ld(&bar[XB_TOPGEN]) == tg, bar);
            __builtin_amdgcn_fence(__ATOMIC_ACQUIRE, "agent");
            xb_add(&bar[XB_XGEN(b.x)], 1u);
            asm volatile("s_waitcnt vmcnt(0)" ::: "memory");
        } else {
            XB_SPIN(xb_ld(&bar[XB_XGEN(b.x)]) == gen, bar);
            __builtin_amdgcn_fence(__ATOMIC_ACQUIRE, "agent");
            asm volatile("s_waitcnt vmcnt(0)" ::: "memory");
        }
    }
    __syncthreads();
}

__device__ __forceinline__ void team_barrier(unsigned* cnt, unsigned np) {
    VM_WAIT(); __syncthreads();
    if (threadIdx.x == 0) {
        __builtin_amdgcn_fence(__ATOMIC_RELEASE, "agent"); VM_WAIT();
        __hip_atomic_fetch_add(cnt, 1u, __ATOMIC_RELAXED, __HIP_MEMORY_SCOPE_AGENT);
        unsigned sp = 0;
        while (__hip_atomic_load(cnt, __ATOMIC_RELAXED, __HIP_MEMORY_SCOPE_AGENT) < np) { __builtin_amdgcn_s_sleep(2); if (++sp > (1u << 22)) break; }
        __builtin_amdgcn_fence(__ATOMIC_ACQUIRE, "agent"); VM_WAIT();
    }
    __syncthreads();
}
__device__ __forceinline__ void p0_transpose_item(const float* W, int K, int N, bf16* WT, LAS float* scr, int item, int lane) {
    const int nblk = N / 32, kb = item / nblk, nb = item % nblk, k0 = 64 * kb, n0 = 32 * nb;
#pragma unroll 8
    for (int i = 0; i < 32; ++i) { const int kk = 2 * i + (lane >> 5); scr[kk * 33 + (lane & 31)] = W[(size_t)(k0 + kk) * N + n0 + (lane & 31)]; }
    LDS_WAIT(); asm volatile("" ::: "memory");
    const int c = lane & 7;
#pragma unroll
    for (int j = 0; j < 4; ++j) { const int n = (lane >> 3) + 8 * j; const LAS float* s = scr + (8 * c) * 33 + n;
        v4u o; o.x = pk2(s[0 * 33], s[1 * 33]); o.y = pk2(s[2 * 33], s[3 * 33]); o.z = pk2(s[4 * 33], s[5 * 33]); o.w = pk2(s[6 * 33], s[7 * 33]);
        *(GAS v4u*)(WT + (size_t)(n0 + n) * K + k0 + 8 * c) = o; }
    LDS_WAIT(); asm volatile("" ::: "memory");
}
template <int NR> __device__ __forceinline__ void rms_rows_to_bf16(const float* x0, size_t xstride, const float* g, bf16* o0, size_t ostride, int lane) {
    const GAS f32x4* gr = (const GAS f32x4*)g + lane;
    f32x4 v[NR][4]; float s[NR];
#pragma unroll
    for (int r = 0; r < NR; ++r) { const GAS f32x4* xr = (const GAS f32x4*)(x0 + r * xstride) + lane;
#pragma unroll
        for (int j = 0; j < 4; ++j) v[r][j] = xr[64 * j]; }
#pragma unroll
    for (int r = 0; r < NR; ++r) { float a = 0.f;
#pragma unroll
        for (int j = 0; j < 4; ++j) a += (v[r][j].x * v[r][j].x + v[r][j].y * v[r][j].y) + (v[r][j].z * v[r][j].z + v[r][j].w * v[r][j].w);
        s[r] = a; }
#pragma unroll
    for (int r = 0; r < NR; ++r) { const float rstd = __builtin_amdgcn_rsqf(wsum(s[r]) * (1.f / D) + RMS_EPS);
        GAS unsigned long long* o8 = (GAS unsigned long long*)(o0 + r * ostride) + lane;
#pragma unroll
        for (int j = 0; j < 4; ++j) { const f32x4 gg = gr[64 * j]; o8[64 * j] = (unsigned long long)pk2(v[r][j].x * rstd * gg.x, v[r][j].y * rstd * gg.y) | ((unsigned long long)pk2(v[r][j].z * rstd * gg.z, v[r][j].w * rstd * gg.w) << 32); } }
}
template <int NR> __device__ __forceinline__ void rms_rows_inplace(float* x0, size_t xstride, const float* g, int lane) {
    const GAS f32x4* gr = (const GAS f32x4*)g + lane;
    f32x4 v[NR][4]; float s[NR];
#pragma unroll
    for (int r = 0; r < NR; ++r) { const GAS f32x4* xr = (const GAS f32x4*)(x0 + r * xstride) + lane;
#pragma unroll
        for (int j = 0; j < 4; ++j) v[r][j] = xr[64 * j]; }
#pragma unroll
    for (int r = 0; r < NR; ++r) { float a = 0.f;
#pragma unroll
        for (int j = 0; j < 4; ++j) a += (v[r][j].x * v[r][j].x + v[r][j].y * v[r][j].y) + (v[r][j].z * v[r][j].z + v[r][j].w * v[r][j].w);
        s[r] = a; }
#pragma unroll
    for (int r = 0; r < NR; ++r) { const float rstd = __builtin_amdgcn_rsqf(wsum(s[r]) * (1.f / D) + RMS_EPS);
        GAS f32x4* xr = (GAS f32x4*)(x0 + r * xstride) + lane;
#pragma unroll
        for (int j = 0; j < 4; ++j) { const f32x4 gg = gr[64 * j]; xr[64 * j] = v[r][j] * rstd * gg; } }
}

__device__ __forceinline__ void lora_in_row(const bf16* Z, const float* mu, bf16* AL, int m, int lane) {
    const int c = 4 * lane;
    const v2u zc = *(const GAS v2u*)(Z + (size_t)m * INW + 2304 + c);
    const bool hasp = (m % T) != 0;
    const v2u zp = *(const GAS v2u*)(Z + (size_t)(hasp ? m - 1 : m) * INW + 2304 + c);
    const float fac = hasp ? 1.f : 0.f;
    const f32x4 mv = *(const GAS f32x4*)(mu + 1536 + c);
    float z[4] = {bflo(zc.x), bfhi(zc.x), bflo(zc.y), bfhi(zc.y)}, p[4] = {bflo(zp.x) * fac, bfhi(zp.x) * fac, bflo(zp.y) * fac, bfhi(zp.y) * fac}, o[4];
#pragma unroll
    for (int j = 0; j < 4; ++j) { const float v = z[j] + (p[j] - z[j]) * mv[j];
        o[j] = (c < 64) ? (1.f - 2.f / (1.f + __expf(2.f * v))) : ((c < 128) ? v : sigmoidf_(v)); }
    v2u w; w.x = pk2(o[0], o[1]); w.y = pk2(o[2], o[3]);
    *(GAS v2u*)(AL + (size_t)m * KLORA + c) = w;
}

constexpr int AT_KSTR = 144, AT_VSTR = 520, AT_VOFF = 256 * AT_KSTR;
__device__ __forceinline__ int crow(int r, int hi) { return (r & 3) + 8 * (r >> 2) + 4 * hi; }
__device__ __forceinline__ void attn_unit(LAS unsigned char* lds, const bf16* Z, bf16* MIX, const float* sinks, int b, int nb, int kvh) {
    const int tid = threadIdx.x, wid = __builtin_amdgcn_readfirstlane(tid >> 6), lane = tid & 63;
    __syncthreads();
#pragma unroll
    for (int i = 0; i < 4; ++i) {
        const int chunk = tid + 512 * i, key = chunk >> 3, c8 = chunk & 7, kpos = nb * 128 - 128 + key;
        v4u kv = (v4u){0u, 0u, 0u, 0u}, vv = (v4u){0u, 0u, 0u, 0u};
        if (kpos >= 0) { const bf16* zr = Z + (size_t)(b * T + kpos) * INW + 512 + kvh * 64 + c8 * 8; kv = *(const GAS v4u*)zr; vv = *(const GAS v4u*)(zr + 128); }
        *(LAS v4u*)(lds + key * AT_KSTR + c8 * 16) = kv;
        LAS unsigned short* vt = (LAS unsigned short*)(lds + AT_VOFF + (c8 * 8) * AT_VSTR + key * 2);
#pragma unroll
        for (int e = 0; e < 4; ++e) { vt[(2 * e) * (AT_VSTR / 2)] = (unsigned short)(vv[e] & 0xffffu); vt[(2 * e + 1) * (AT_VSTR / 2)] = (unsigned short)(vv[e] >> 16); }
    }
    __syncthreads();
    const int g = wid >> 1, hq = kvh * 4 + g, qhalf = wid & 1, q = lane & 31, hh = lane >> 5;
    const float slope = exp2f(-(float)(hq + 1)), sink = sinks[hq];
    for (int qt = 0; qt < 2; ++qt) {
        const int q0 = qhalf * 64 + qt * 32, qi = q0 + q, kt0 = q0 >> 5; const size_t m = (size_t)b * T + nb * 128 + qi;
        bf16x8 qf[4];
#pragma unroll
        for (int s = 0; s < 4; ++s) qf[s] = *(const GAS bf16x8*)(Z + m * INW + hq * 64 + 16 * s + 8 * hh);
        f32x16 sc[5];
#pragma unroll
        for (int i = 0; i < 5; ++i) {
#pragma unroll
            for (int r = 0; r < 16; ++r) sc[i][r] = 0.f;
#pragma unroll
            for (int s = 0; s < 4; ++s) { const bf16x8 a = *(const LAS bf16x8*)(lds + (32 * (kt0 + i) + q) * AT_KSTR + (16 * s + 8 * hh) * 2); sc[i] = __builtin_amdgcn_mfma_f32_32x32x16_bf16(a, qf[s], sc[i], 0, 0, 0); }
        }
        float mx = -1e30f;
#pragma unroll
        for (int i = 0; i < 5; ++i)
#pragma unroll
            for (int r = 0; r < 16; ++r) { const int kj = 32 * (kt0 + i) + crow(r, hh), dist = qi - kj + 128; const bool valid = (dist >= 0) && (dist < 128) && (nb * 128 - 128 + kj >= 0);
                const float v = valid ? (sc[i][r] * 0.125f - slope * (float)dist) : -1e30f; sc[i][r] = v; mx = fmaxf(mx, v); }
        mx = fmaxf(mx, __shfl_xor(mx, 32)); mx = fmaxf(mx, sink);
        float sum = 0.f;
#pragma unroll
        for (int i = 0; i < 5; ++i)
#pragma unroll
            for (int r = 0; r < 16; ++r) { const float e = __expf(sc[i][r] - mx); sc[i][r] = e; sum += e; }
        sum += __shfl_xor(sum, 32);
        const float inv = 1.0f / (sum + __expf(sink - mx));
        f32x16 o[2];
#pragma unroll
        for (int r = 0; r < 16; ++r) { o[0][r] = 0.f; o[1][r] = 0.f; }
#pragma unroll
        for (int i = 0; i < 5; ++i)
#pragma unroll
            for (int s = 0; s < 2; ++s) {
                v4u pw;
#pragma unroll
                for (int j = 0; j < 4; ++j) pw[j] = pk2(sc[i][8 * s + 2 * j] * inv, sc[i][8 * s + 2 * j + 1] * inv);
                const bf16x8 xs = __builtin_bit_cast(bf16x8, pw);
                const int kb = 32 * (kt0 + i) + 16 * s + 4 * hh;
#pragma unroll
                for (int dt = 0; dt < 2; ++dt) { const LAS unsigned char* vp = lds + AT_VOFF + (dt * 32 + q) * AT_VSTR + kb * 2;
                    const s16x4 lo = *(const LAS s16x4*)vp, hi = *(const LAS s16x4*)(vp + 16);
                    const bf16x8 pa = __builtin_shufflevector(lo, hi, 0, 1, 2, 3, 4, 5, 6, 7);
                    o[dt] = __builtin_amdgcn_mfma_f32_32x32x16_bf16(pa, xs, o[dt], 0, 0, 0); }
            }
        bf16* orow = MIX + m * D + hq * 64 + 4 * hh;
#pragma unroll
        for (int dt = 0; dt < 2; ++dt)
#pragma unroll
            for (int r4 = 0; r4 < 4; ++r4) { v2u w; w.x = pk2(o[dt][4 * r4], o[dt][4 * r4 + 1]); w.y = pk2(o[dt][4 * r4 + 2], o[dt][4 * r4 + 3]); *(GAS v2u*)(orow + dt * 32 + 8 * r4) = w; }
    }
}

constexpr int TC = 16, NCH = T / TC;
constexpr int SC_W = 0, SC_A = TC * 64, SC_B = 2 * TC * 64, SC_K = 3 * TC * 64, SC_R = 4 * TC * 64, SC_V = 5 * TC * 64, SC_G = 6 * TC * 64, SC_BON = 7 * TC * 64, SC_YP = 7 * TC * 64 + 64, SC_BUF = SC_YP + TC * 32 * 4;
static_assert(2 * SC_BUF * 4 <= 131072, "scan LDS");
struct ScanConst { f32x4 mu_r, mu_k, mu_v, w0, a0, kk, ka, rk; };
struct ScanRaw { v2u zr[3], zp[3], lo[3]; float fac; };
__device__ __forceinline__ f32x4 unpack4(v2u p) { return (f32x4){bflo(p.x), bfhi(p.x), bflo(p.y), bfhi(p.y)}; }
__device__ __forceinline__ float sum4(f32x4 v) { return (v.x + v.y) + (v.z + v.w); }
__device__ __forceinline__ void scan_load(ScanRaw& R, const bf16* Z, const bf16* LORA, int b, int h, int t0, int k4, int lane) {
    const int t = 4 * k4 + (lane >> 4), hc = h * 64 + 4 * (lane & 15); const size_t m = (size_t)b * T + t0 + t; const bool hasp = (t0 + t) > 0; R.fac = hasp ? 1.f : 0.f;
    const bf16* zrow = Z + m * INW + ZR0 + hc; const bf16* prow = hasp ? zrow - INW : zrow; const bf16* lrow = LORA + m * NLORA + hc;
#pragma unroll
    for (int j = 0; j < 3; ++j) { R.zr[j] = *(const GAS v2u*)(zrow + 512 * j); R.zp[j] = *(const GAS v2u*)(prow + 512 * j); R.lo[j] = *(const GAS v2u*)(lrow + 512 * j); }
}
__device__ __forceinline__ void scan_store(LAS float* buf, const ScanRaw& R, int k4, int lane, const ScanConst& c) {
    const int t = 4 * k4 + (lane >> 4), cg = lane & 15;
    const f32x4 zr = unpack4(R.zr[0]), zk = unpack4(R.zr[1]), zv = unpack4(R.zr[2]);
    const f32x4 xr = zr + (unpack4(R.zp[0]) * R.fac - zr) * c.mu_r, xk = zk + (unpack4(R.zp[1]) * R.fac - zk) * c.mu_k, xv = zv + (unpack4(R.zp[2]) * R.fac - zv) * c.mu_v;
    const f32x4 lw = unpack4(R.lo[0]) + c.w0, la = unpack4(R.lo[1]) + c.a0, g = unpack4(R.lo[2]);
    f32x4 w, a;
#pragma unroll
    for (int e = 0; e < 4; ++e) { w[e] = __expf(-0.60653066f * sigmoidf_(lw[e])); a[e] = sigmoidf_(la[e]); }
    const f32x4 kkr = xk * c.kk; const float ss = red16(sum4(kkr * kkr)); const f32x4 kk = kkr * __builtin_amdgcn_rsqf(fmaxf(ss, 1e-24f));
    const f32x4 k = xk * (1.f + (a - 1.f) * c.ka);
    const float bon = red16(sum4(xr * k * c.rk));
    *(LAS f32x4*)(buf + SC_W + t * 64 + 4 * cg) = w; *(LAS f32x4*)(buf + SC_A + t * 64 + 4 * cg) = -kk; *(LAS f32x4*)(buf + SC_B + t * 64 + 4 * cg) = kk * a; *(LAS f32x4*)(buf + SC_K + t * 64 + 4 * cg) = k;
    *(LAS f32x4*)(buf + SC_R + t * 64 + 4 * cg) = xr; *(LAS f32x4*)(buf + SC_V + t * 64 + 4 * cg) = xv; *(LAS f32x4*)(buf + SC_G + t * 64 + 4 * cg) = g; if (cg == 0) buf[SC_BON + t] = bon;
}
__device__ __forceinline__ void scan_output(const LAS float* buf, float* Y, bf16* PB, bf16* QB, int b, int h, int half, int t0, int k4, int lane, f32x2 lnw2, f32x2 lnb2) {
    const int t = 4 * k4 + (lane >> 4), cg = lane & 15, row = half * 32 + 2 * cg; const size_t m = (size_t)b * T + t0 + t;
    const LAS f32x4* yp = (const LAS f32x4*)(buf + SC_YP + (t * 32 + 2 * cg) * 4);
    f32x2 y; y.x = sum4(yp[0]); y.y = sum4(yp[1]);
    const f32x2 v = *(const LAS f32x2*)(buf + SC_V + t * 64 + row), g = *(const LAS f32x2*)(buf + SC_G + t * 64 + row);
    const float bon = buf[SC_BON + t];
    const f32x2 P = g * lnw2, Q = (lnb2 + v * bon) * g;
    const size_t off = m * 512 + h * 64 + row;
    *(GAS f32x2*)(Y + off) = y; *(GAS unsigned*)(PB + off) = pk2(P.x, P.y); *(GAS unsigned*)(QB + off) = pk2(Q.x, Q.y);
}
struct ScanOps { f32x4 a, w, b, k, r; float v0, v1; };
__device__ __forceinline__ void scan_ops_load(ScanOps& o, const LAS float* buf, int t, int slice, int vrow) {
    o.a = *(const LAS f32x4*)(buf + SC_A + t * 64 + slice * 4); o.w = *(const LAS f32x4*)(buf + SC_W + t * 64 + slice * 4); o.b = *(const LAS f32x4*)(buf + SC_B + t * 64 + slice * 4);
    o.k = *(const LAS f32x4*)(buf + SC_K + t * 64 + slice * 4); o.r = *(const LAS f32x4*)(buf + SC_R + t * 64 + slice * 4);
    o.v0 = buf[SC_V + t * 64 + vrow]; o.v1 = buf[SC_V + t * 64 + vrow + 16];
}
__device__ __forceinline__ void scan_steps(LAS float* buf, f32x2 (&S0)[2], f32x2 (&S1)[2], int slice, int rq, int vrow) {
    ScanOps cur; scan_ops_load(cur, buf, 0, slice, vrow);
    float yp0 = 0.f, yp1 = 0.f;
#pragma unroll
    for (int t = 0; t < TC; ++t) {
        ScanOps nxt; if (t + 1 < TC) scan_ops_load(nxt, buf, t + 1, slice, vrow);
        __builtin_amdgcn_sched_barrier(0);
        const f32x2 a[2] = {cur.a.xy, cur.a.zw}, w[2] = {cur.w.xy, cur.w.zw}, bb[2] = {cur.b.xy, cur.b.zw}, k[2] = {cur.k.xy, cur.k.zw}, r[2] = {cur.r.xy, cur.r.zw};
        const f32x2 d0 = S0[0] * a[0] + S0[1] * a[1], d1 = S1[0] * a[0] + S1[1] * a[1];
        float e0 = d0.x + d0.y, e1 = d1.x + d1.y;
        e0 += dppf<0xB1>(e0); e1 += dppf<0xB1>(e1); yp0 += dppf<0xB1>(yp0); yp1 += dppf<0xB1>(yp1);
        e0 += dppf<0x4E>(e0); e1 += dppf<0x4E>(e1); yp0 += dppf<0x4E>(yp0); yp1 += dppf<0x4E>(yp1);
        e0 += dppf<0x141>(e0); e1 += dppf<0x141>(e1);
        if (t > 0) { buf[SC_YP + ((t - 1) * 32 + rq) * 4 + (slice >> 2)] = yp0; buf[SC_YP + ((t - 1) * 32 + rq + 16) * 4 + (slice >> 2)] = yp1; }
        e0 += dppf<0x140>(e0); e1 += dppf<0x140>(e1);
        const f32x2 sa0v = {e0, e0}, sa1v = {e1, e1}, v0v = {cur.v0, cur.v0}, v1v = {cur.v1, cur.v1};
#pragma unroll
        for (int q = 0; q < 2; ++q) { S0[q] = S0[q] * w[q] + (sa0v * bb[q] + v0v * k[q]); S1[q] = S1[q] * w[q] + (sa1v * bb[q] + v1v * k[q]); }
        const f32x2 y0 = S0[0] * r[0] + S0[1] * r[1], y1 = S1[0] * r[0] + S1[1] * r[1];
        yp0 = y0.x + y0.y; yp1 = y1.x + y1.y;
        __builtin_amdgcn_sched_barrier(0);
        if (t + 1 < TC) cur = nxt;
    }
    yp0 = red4(yp0); yp1 = red4(yp1);
    buf[SC_YP + ((TC - 1) * 32 + rq) * 4 + (slice >> 2)] = yp0; buf[SC_YP + ((TC - 1) * 32 + rq + 16) * 4 + (slice >> 2)] = yp1;
}
__device__ __forceinline__ void scan_unit(LAS float* lds, const bf16* Z, const bf16* LORA, float* Y, bf16* PB, bf16* QB, const Args& args, int b, int h, int half) {
    const int tid = threadIdx.x, wid = __builtin_amdgcn_readfirstlane(tid >> 6), lane = tid & 63;
    __syncthreads();
    if (wid < 4) {
        const int slice = tid & 15, rq = tid >> 4, vrow = half * 32 + rq;
        f32x2 S0[2], S1[2];
#pragma unroll
        for (int q = 0; q < 2; ++q) { S0[q] = (f32x2){0.f, 0.f}; S1[q] = (f32x2){0.f, 0.f}; }
        WG_BAR_LDS();
        for (int ch = 0; ch < NCH; ++ch) { scan_steps(lds + (ch & 1) * SC_BUF, S0, S1, slice, rq, vrow); WG_BAR_LDS(); }
    } else {
        const int k4 = wid - 4, hc4 = h * 64 + 4 * (lane & 15), row = h * 64 + half * 32 + 2 * (lane & 15);
        ScanConst c; c.mu_r = *(const GAS f32x4*)(args.in[4] + hc4); c.mu_k = *(const GAS f32x4*)(args.in[4] + 512 + hc4); c.mu_v = *(const GAS f32x4*)(args.in[4] + 1024 + hc4); c.w0 = *(const GAS f32x4*)(args.in[5] + hc4); c.a0 = *(const GAS f32x4*)(args.in[7] + hc4);
        c.kk = *(const GAS f32x4*)(args.in[10] + hc4); c.ka = *(const GAS f32x4*)(args.in[11] + hc4); c.rk = *(const GAS f32x4*)(args.in[12] + hc4);
        const f32x2 lnw2 = *(const GAS f32x2*)(args.in[13] + row), lnb2 = *(const GAS f32x2*)(args.in[14] + row);
        ScanRaw Re, Ro; scan_load(Re, Z, LORA, b, h, 0, k4, lane); scan_store(lds, Re, k4, lane, c); scan_load(Ro, Z, LORA, b, h, TC, k4, lane); scan_load(Re, Z, LORA, b, h, 2 * TC, k4, lane);
        WG_BAR_LDS();
        for (int ch = 0; ch < NCH; ch += 2) {
            {
                LAS float* oth = lds + SC_BUF;
                if (ch > 0) scan_output(oth, Y, PB, QB, b, h, half, (ch - 1) * TC, k4, lane, lnw2, lnb2);
                scan_store(oth, Ro, k4, lane, c);
                if (ch + 3 < NCH) scan_load(Ro, Z, LORA, b, h, (ch + 3) * TC, k4, lane);
                WG_BAR_LDS();
            }
            {
                LAS float* oth = lds;
                scan_output(oth, Y, PB, QB, b, h, half, ch * TC, k4, lane, lnw2, lnb2);
                if (ch + 2 < NCH) { scan_store(oth, Re, k4, lane, c); if (ch + 4 < NCH) scan_load(Re, Z, LORA, b, h, (ch + 4) * TC, k4, lane); }
                WG_BAR_LDS();
            }
        }
        scan_output(lds + ((NCH - 1) & 1) * SC_BUF, Y, PB, QB, b, h, half, (NCH - 1) * TC, k4, lane, lnw2, lnb2);
    }
    __syncthreads();
}
__device__ __forceinline__ void rwkv_post_panel(const float* Y, const bf16* PB, const bf16* QB, bf16* MIX, int pm, int wave, int lane) {
    const int tsub = lane >> 4, cg = lane & 15;
    for (int j0 = 0; j0 < 64; j0 += 4) {
        f32x4 y[4]; v2u p[4], q[4];
#pragma unroll
        for (int u = 0; u < 4; ++u) { const size_t off = (size_t)(pm * 256 + (j0 + u) * 4 + tsub) * 512 + wave * 64 + 4 * cg; y[u] = *(const GAS f32x4*)(Y + off); p[u] = *(const GAS v2u*)(PB + off); q[u] = *(const GAS v2u*)(QB + off); }
#pragma unroll
        for (int u = 0; u < 4; ++u) { const size_t m = (size_t)(pm * 256 + (j0 + u) * 4 + tsub);
            const float mean = red16(sum4(y[u])) * (1.f / 64.f); const f32x4 d = y[u] - mean; const float var = red16(sum4(d * d)) * (1.f / 64.f);
            const f32x4 o = d * __builtin_amdgcn_rsqf(var + GN_EPS) * unpack4(p[u]) + unpack4(q[u]);
            v2u pw; pw.x = pk2(o[0], o[1]); pw.y = pk2(o[2], o[3]);
            *(GAS v2u*)(MIX + m * D + 512 + wave * 64 + 4 * cg) = pw; }
    }
}

__global__ void __launch_bounds__(NWAVES * 64, 2) mk_fwd(Args args) {
    extern __shared__ __attribute__((aligned(16))) unsigned char lds_raw[];
    LAS unsigned char* lds = (LAS unsigned char*)lds_raw;
    cg::grid_group grid = cg::this_grid();
    volatile LAS unsigned* bar_st = (volatile LAS unsigned*)(lds + 131072 + 64);
    if (threadIdx.x == 0) { bar_st[0] = 0u; bar_st[1] = 0u; }
    __syncthreads();
    const int tid = threadIdx.x, lane = tid & 63, wave = __builtin_amdgcn_readfirstlane(tid >> 6);
    const int G = gridDim.x, bx = blockIdx.x;
    unsigned char* ws = args.ws;
    const float* x = args.in[0]; float* out = args.out;
    bf16* WIN = (bf16*)(ws + WS_WIN); bf16* WOUT = (bf16*)(ws + WS_WOUT); bf16* WUP = (bf16*)(ws + WS_WUP); bf16* WDOWN = (bf16*)(ws + WS_WDOWN); bf16* BL = (bf16*)(ws + WS_BL);
    bf16* MIX = (bf16*)(ws + WS_MIX); float* Yb = (float*)(ws + WS_XN); bf16* PB = (bf16*)(ws + WS_PB); bf16* QB = (bf16*)(ws + WS_QB); bf16* XN = (bf16*)(ws + WS_XN); bf16* Zb = (bf16*)(ws + WS_Z); bf16* AL = (bf16*)(ws + WS_ALORA); bf16* LORA = (bf16*)(ws + WS_LORA); bf16* HB = (bf16*)(ws + WS_H);

    {
        LAS float* scr = (LAS float*)(lds + wave * 16384);
        const int gw = bx * NWAVES + wave, NGW = G * NWAVES;
        constexpr int I_IN = (D / 64) * (INW / 32), I_OUT = (D / 64) * (D / 32), I_UP = (D / 64) * (FF / 32), I_DN = (FF / 64) * (D / 32);
        constexpr int NITEMS = I_IN + I_OUT + I_UP + I_DN;
        for (int it = gw; it < NITEMS; it += NGW) {
            int r = it;
            if (r < I_IN) { p0_transpose_item(args.in[2], D, INW, WIN, scr, r, lane); continue; } r -= I_IN;
            if (r < I_OUT) { p0_transpose_item(args.in[15], D, D, WOUT, scr, r, lane); continue; } r -= I_OUT;
            if (r < I_UP) { p0_transpose_item(args.in[17], D, FF, WUP, scr, r, lane); continue; } r -= I_UP;
            p0_transpose_item(args.in[18], FF, D, WDOWN, scr, r, lane);
        }
        if (bx == 0) for (int i = tid; i < 32768; i += NWAVES * 64) ((unsigned*)ws)[i] = 0u;
        for (int idx = bx * (NWAVES * 64) + tid; idx < NLORA * KLORA; idx += G * NWAVES * 64) {
            const int n = idx / KLORA, k = idx % KLORA; float v = 0.f;
            if (n < 512) { if (k < 64) v = args.in[6][k * 512 + n]; }
            else if (n < 1024) { if (k >= 64 && k < 128) v = args.in[8][(k - 64) * 512 + (n - 512)]; }
            else { if (k >= 128) v = args.in[9][(k - 128) * 512 + (n - 1024)]; }
            BL[idx] = (bf16)f2bf(v);
        }
        for (int m = gw * 4; m < M; m += NGW * 4) rms_rows_to_bf16<4>(x + (size_t)m * D, D, args.in[1], XN + (size_t)m * D, D, lane);
    }
    grid.sync();
    const XcdBarrier xbar = xcd_barrier_post((unsigned*)ws + 16384, bar_st);
    for (int rep_ = 0; rep_ < REP_P1; ++rep_) {
        pg8::Gemm g{XN, WIN, M, INW, D};
        const int pr = (bx >> 3) & 1, pbase = (bx & ~8);
        pg8::TeamOrder S{pbase, 8, pr * 5, 2, 5};
        pg8::EpiBf16<0> E{Zb, INW, nullptr, 0, 0, 1.f};
        pg8::gemm_phase<pg8::EpiBf16<0>, pg8::TeamOrder, PG8_ALIGN, PG8_SP2>(lds, g, S, E);
    }
    xcd_barrier(xbar);
    if (bx < M / 256) { const int pm = bx;
        for (int r = wave * 4; r < 256; r += NWAVES * 4) {
#pragma unroll
            for (int q = 0; q < 4; ++q) lora_in_row(Zb, args.in[4], AL, pm * 256 + r + q, lane); }
        wg_global_sync();
        pg8::Gemm g{AL, BL, M, NLORA, KLORA}; pg8::PanelOrder S{pm, NLORA / 256};
        pg8::EpiBf16<0> E{LORA, NLORA, nullptr, 0, 0, 1.f};
#ifndef NO_P1B
        pg8::gemm_phase<pg8::EpiBf16<0>, pg8::PanelOrder, PG8_ALIGN, PG8_SP2>(lds, g, S, E);
#endif
    }
    xcd_barrier(xbar);
    {
        for (int u = bx; u < BATCH * 32 * 2; u += G) attn_unit(lds, Zb, MIX, args.in[3], u >> 6, (u >> 1) & 31, u & 1);
        for (int u = bx; u < BATCH * 16; u += G) scan_unit((LAS float*)lds, Zb, LORA, Yb, PB, QB, args, u >> 4, (u >> 1) & 7, u & 1);
    }
    xcd_barrier(xbar);
    if (bx < M / 256) { const int pm = bx;
        const int xq = bx & 7, role = (bx >> 3) & 3, q = bx >> 5, tp0 = q * 32 + xq; unsigned* tcnt = (unsigned*)ws + (size_t)(q * 8 + xq) * 256;
        rwkv_post_panel(Yb, PB, QB, MIX, pm, wave, lane);
        team_barrier(tcnt, 4u);
        { pg8::Gemm g{MIX, WOUT, M, D, D}; pg8::TeamOrder S{tp0, 8, role, 4, 1}; pg8::EpiResF32 E{x, out, D};
          pg8::gemm_phase<pg8::EpiResF32, pg8::TeamOrder, PG8_ALIGN, PG8_SP2>(lds, g, S, E); }
        team_barrier(tcnt + 32, 4u);
        for (int r = wave * 4; r < 256; r += NWAVES * 4) rms_rows_to_bf16<4>(out + (size_t)(pm * 256 + r) * D, D, args.in[16], XN + (size_t)(pm * 256 + r) * D, D, lane);
        team_barrier(tcnt + 64, 4u);
        { pg8::Gemm g{XN, WUP, M, FF, D}; pg8::TeamOrder S{tp0, 8, role * 4, 4, 4}; pg8::EpiBf16<2> E{HB, FF, nullptr, 0, 0, 1.f};
          pg8::gemm_phase<pg8::EpiBf16<2>, pg8::TeamOrder, PG8_ALIGN, PG8_SP2>(lds, g, S, E); }
        team_barrier(tcnt + 96, 4u);
        { pg8::Gemm g{HB, WDOWN, M, D, FF}; pg8::TeamOrder S{tp0, 8, role, 4, 1}; pg8::EpiResF32 E{out, out, D};
          pg8::gemm_phase<pg8::EpiResF32, pg8::TeamOrder, PG8_ALIGN, PG8_SP2>(lds, g, S, E); }
        team_barrier(tcnt + 128, 4u);
        for (int r = wave * 4; r < 256; r += NWAVES * 4) rms_rows_inplace<4>(out + (size_t)(pm * 256 + r) * D, D, args.in[19], lane);
    }
}

extern "C" void kernel_launch(void* const* d_in, const int* in_sizes, int n_in, void* d_out, int out_size, void* d_ws, size_t ws_size, hipStream_t stream) {
    static int grid = 0;
    if (grid == 0) {
        if (n_in != 20 || in_sizes[0] != M * D || out_size != M * D || ws_size < WS_END) { fprintf(stderr, "kernel_launch: unexpected shapes (n_in %d, in0 %d, out %d, ws %zu)\n", n_in, n_in > 0 ? in_sizes[0] : -1, out_size, ws_size); grid = -1; return; }
        int dev = 0, cus = 0, per_cu = 0;
        if (hipGetDevice(&dev) != hipSuccess || hipDeviceGetAttribute(&cus, hipDeviceAttributeMultiprocessorCount, dev) != hipSuccess) { grid = -1; return; }
        if (hipFuncSetAttribute((const void*)mk_fwd, hipFuncAttributeMaxDynamicSharedMemorySize, LDS_BYTES) != hipSuccess) { fprintf(stderr, "kernel_launch: hipFuncSetAttribute failed\n"); grid = -1; return; }
        if (hipOccupancyMaxActiveBlocksPerMultiprocessor(&per_cu, (const void*)mk_fwd, NWAVES * 64, LDS_BYTES) != hipSuccess || per_cu < 1) { fprintf(stderr, "kernel_launch: occupancy query says %d\n", per_cu); (void)hipGetLastError(); per_cu = 1; }
        if (cus < M / 256) { fprintf(stderr, "kernel_launch: needs >= 256 CUs\n"); grid = -1; return; }
        grid = M / 256;
    }
    if (grid < 0) return;
    Args a{};
    for (int i = 0; i < 20; ++i) a.in[i] = (const float*)d_in[i];
    a.out = (float*)d_out; a.ws = (unsigned char*)d_ws;
    void* kargs[] = {&a};
    hipError_t e = hipLaunchCooperativeKernel((const void*)mk_fwd, dim3(grid), dim3(NWAVES * 64), kargs, LDS_BYTES, stream);
    if (e != hipSuccess) fprintf(stderr, "kernel_launch: cooperative launch failed: %s (grid %d)\n", hipGetErrorString(e), grid);
}
```

```cpp
#include <hip/hip_runtime.h>
#include <hip/hip_cooperative_groups.h>
#include <cstdio>
#include <cstdint>
namespace cg = cooperative_groups;
namespace pg8 {
#define PG8_LAS __attribute__((address_space(3)))
typedef unsigned short bf16_t;
typedef short bf16x8 __attribute__((ext_vector_type(8)));
typedef float f32x4 __attribute__((ext_vector_type(4)));
typedef unsigned u32x4 __attribute__((ext_vector_type(4)));
constexpr int BM = 256, BK = 64, HALF = 128, HTB = HALF * BK * 2  , STAGE_BYTES = 8 * HTB, NXCD = 8, WGM = 8;

__host__ __device__ __forceinline__ int lds_byte(int r, int c) { const int st = (r >> 4) * 2 + (c >> 5), rr = r & 15, cc = c & 31, ob = rr * 64 + cc * 2; return st * 1024 + (ob ^ (((ob >> 9) & 1) << 5)); }
__host__ __device__ __forceinline__ void stage_rc(int b, int& R, int& C) { const int st = b / 1024, sb = b % 1024, swz = sb ^ (((sb >> 9) & 1) << 5); R = (st >> 1) * 16 + swz / 64; C = (st & 1) * 32 + (swz % 64) / 2; }
__host__ __device__ __forceinline__ int perm32(int rho) { const int n = rho >> 4, i = rho & 15; return 8 * (i >> 2) + 4 * n + (i & 3); }

struct Unit { int pm, pn; };
struct Gemm { const bf16_t* A; const bf16_t* Bt; int M, N, K; };

struct StaticOrder {
    int nM, nN, nwg, G, c;
    __host__ __device__ void init(int M, int N, int G_, int c_) { nM = M / BM; nN = N / BM; nwg = nM * nN; G = G_; c = c_; }
    __host__ __device__ bool next(int i, Unit& u) const {
        const long L = (long)i * G + c; if (L >= nwg) return false;
        int wgid = (int)L; { const int q = nwg / NXCD, r = nwg % NXCD, xcd = wgid % NXCD, off = wgid / NXCD; wgid = (xcd < r ? xcd * (q + 1) : r * (q + 1) + (xcd - r) * q) + off; }
        const int nig = WGM * nN, gid = wgid / nig, fm = gid * WGM, gsz = (nM - fm) < WGM ? (nM - fm) : WGM;
        u.pm = fm + ((wgid % nig) % gsz); u.pn = (wgid % nig) / gsz; return true;
    }
    __device__ __forceinline__ void a_ready(const Unit&) const {}
    __device__ __forceinline__ void done(const Unit&) const {}
};

__device__ __forceinline__ unsigned cvt_pk_bf16(float lo, float hi) { unsigned r; asm volatile("v_cvt_pk_bf16_f32 %0, %1, %2" : "=v"(r) : "v"(lo), "v"(hi)); return r; }
template <int N> __device__ __forceinline__ float row_shr_add(float x) { return x + __builtin_bit_cast(float, __builtin_amdgcn_update_dpp(0, __builtin_bit_cast(int, x), 0x110 + N, 0xF, 0xF, true)); }
__device__ __forceinline__ float row_prefix16(float x) { x = row_shr_add<1>(x); x = row_shr_add<2>(x); x = row_shr_add<4>(x); x = row_shr_add<8>(x); return x; }
template <int ACT  > struct EpiBf16 {
    static constexpr bool PERM = true, AFTER_DRAIN = false; static_assert(ACT == 0 || ACT == 2 || ACT == 3, "EpiBf16: ACT is 0 (none), 2 (relu squared) or 3 (RWKV LoRA heads: column tiles 0-1 cumulative log-decay per 16-row chunk, 2-3 sigmoid, 4-5 identity)");
    bf16_t* O; int ldc; const float* bias; int split_cols; size_t split_stride; float scale0;
    __device__ __forceinline__ void operator()(const f32x4 (&acc)[2][2][4][2], const Unit& u, int wr, int wc, int fr, int fq) const {
        const int row0 = u.pm * BM + wr * 64 + fr; int colt = u.pn * BM; bf16_t* base = O;
        float sc = 1.f; if (split_cols) { const int t = colt / split_cols; base += (size_t)t * split_stride; colt -= t * split_cols; if (t == 0) sc = scale0; }
        const int col0 = colt + wc * 32 + 8 * fq, bcol0 = u.pn * BM + wc * 32 + 8 * fq;
        f32x4 bv[2][2];
#pragma unroll
        for (int bj = 0; bj < 2; ++bj)
#pragma unroll
            for (int n = 0; n < 2; ++n) bv[bj][n] = bias ? *(const f32x4*)(bias + bcol0 + bj * HALF + 4 * n) : (f32x4){0.f, 0.f, 0.f, 0.f};
#pragma unroll
        for (int ai = 0; ai < 2; ++ai)
#pragma unroll
            for (int m = 0; m < 4; ++m) { bf16_t* rowp = base + (size_t)(row0 + ai * HALF + m * 16) * ldc + col0;
#pragma unroll
                for (int bj = 0; bj < 2; ++bj) { f32x4 v0 = acc[ai][bj][m][0] + bv[bj][0], v1 = acc[ai][bj][m][1] + bv[bj][1];
                    if (ACT == 3) { if (u.pn < 4) { const float sc3 = u.pn < 2 ? -0.60653066f : 1.0f;
#pragma unroll
                        for (int e = 0; e < 4; ++e) { v0[e] = sc3 * __builtin_amdgcn_rcpf(1.0f + __expf(-v0[e])); v1[e] = sc3 * __builtin_amdgcn_rcpf(1.0f + __expf(-v1[e])); }
                        if (u.pn < 2) {
#pragma unroll
                            for (int e = 0; e < 4; ++e) { v0[e] = row_prefix16(v0[e]); v1[e] = row_prefix16(v1[e]); } } } }
                    if (ACT == 2) { v0 = __builtin_elementwise_max(v0, (f32x4){0.f, 0.f, 0.f, 0.f}); v1 = __builtin_elementwise_max(v1, (f32x4){0.f, 0.f, 0.f, 0.f}); v0 = v0 * v0; v1 = v1 * v1; }
                    v0 = v0 * sc; v1 = v1 * sc; u32x4 w; w.x = cvt_pk_bf16(v0[0], v0[1]); w.y = cvt_pk_bf16(v0[2], v0[3]); w.z = cvt_pk_bf16(v1[0], v1[1]); w.w = cvt_pk_bf16(v1[2], v1[3]);
                    *(u32x4*)(rowp + bj * HALF) = w; } }
    }
};
struct EpiResF32 {
    static constexpr bool PERM = false, AFTER_DRAIN = false;
    const float* base; float* out; int ldc;
    __device__ __forceinline__ void operator()(const f32x4 (&acc)[2][2][4][2], const Unit& u, int wr, int wc, int fr, int fq) const {
        const int col0 = u.pn * BM + wc * 32 + 4 * fq;
#pragma unroll
        for (int ai = 0; ai < 2; ++ai)
#pragma unroll
            for (int m = 0; m < 4; ++m) { const int r = ai * HALF + wr * 64 + m * 16 + fr; const size_t off = (size_t)(u.pm * BM + r) * ldc + col0;
#pragma unroll
                for (int bj = 0; bj < 2; ++bj)
#pragma unroll
                    for (int n = 0; n < 2; ++n) { const f32x4 bs = *(const f32x4*)(base + off + bj * HALF + n * 16); const f32x4 o = bs + acc[ai][bj][m][n]; *(f32x4*)(out + off + bj * HALF + n * 16) = o; }
                if (m & 1) asm volatile("" ::: "memory"); }
    }
};
struct PanelOrder {
    int pm, nN;
    __device__ __forceinline__ bool next(int i, Unit& u) const { if (i >= nN) return false; u.pm = pm; u.pn = i; return true; }
    __device__ __forceinline__ void a_ready(const Unit&) const {}
    __device__ __forceinline__ void done(const Unit&) const {}
};
struct TeamOrder {
    int pm0, pstride, pn0, np, nt;
    __device__ __forceinline__ bool next(int i, Unit& u) const { if (i >= np * nt) return false; u.pm = pm0 + (i / nt) * pstride; u.pn = pn0 + (i % nt); return true; }
    __device__ __forceinline__ void a_ready(const Unit&) const {}
    __device__ __forceinline__ void done(const Unit&) const {}
};
template <class Epi, class Sched, bool ALIGN_EPI = false, bool SP2 = false>
__device__ __forceinline__ void gemm_phase(PG8_LAS unsigned char* lds, const Gemm g, const Sched& S, const Epi& E) {
    int tid_ = threadIdx.x; asm volatile("" : "+v"(tid_));
    const int tid = tid_, wid = __builtin_amdgcn_readfirstlane(tid >> 6), lane = tid & 63, wr = wid >> 2, wc = wid & 3, fr = lane & 15, fq = lane >> 4;
    const int K = g.K, nt = K / BK;
    unsigned voffA[2], voffB[2];
#pragma unroll
    for (int i = 0; i < 2; ++i) { int R, C; stage_rc(tid * 16 + i * 8192, R, C); const int Rb = Epi::PERM ? ((R & ~31) + perm32(R & 31)) : R;
        voffA[i] = (unsigned)(R * K + C) * 2u; voffB[i] = (unsigned)(Rb * K + C) * 2u; }
    const size_t kstep = (size_t)(BK * 2);
    const size_t hstep = (size_t)HALF * K * 2;
    const size_t tstep = 2 * hstep;
    const unsigned ldsw = (unsigned)wid * 1024u;
    const int aoff = lds_byte(wr * 64 + fr, fq * 8), boff = lds_byte(wc * 32 + fr, fq * 8);
#define PG8_SA(b, h) (((b) * 2 + (h)) * HTB)
#define PG8_SB(b, h) ((4 + (b) * 2 + (h)) * HTB)
#define PG8_STAGE(bufoff, gbase, voff) do { _Pragma("unroll") for (int _i = 0; _i < 2; ++_i) \
        __builtin_amdgcn_global_load_lds((const unsigned*)((const char*)(gbase) + (voff)[_i]), (PG8_LAS unsigned*)(lds + (bufoff) + ldsw + _i * 8192), 16, 0, 0); } while (0)
#define PG8_LDA(dst, b, h) do { _Pragma("unroll") for (int m = 0; m < 4; ++m) _Pragma("unroll") for (int k = 0; k < 2; ++k) dst[m][k] = *(const PG8_LAS bf16x8*)(lds + PG8_SA(b, h) + aoff + m * 2048 + k * 1024); } while (0)
#define PG8_LDB(dst, b, h) do { _Pragma("unroll") for (int n = 0; n < 2; ++n) _Pragma("unroll") for (int k = 0; k < 2; ++k) dst[n][k] = *(const PG8_LAS bf16x8*)(lds + PG8_SB(b, h) + boff + n * 2048 + k * 1024); } while (0)
#define PG8_MMA(ai, bj, At, Bt) do { __builtin_amdgcn_s_setprio(1); _Pragma("unroll") for (int m = 0; m < 4; ++m) _Pragma("unroll") for (int n = 0; n < 2; ++n) _Pragma("unroll") for (int k = 0; k < 2; ++k) \
        acc[ai][bj][m][n] = __builtin_amdgcn_mfma_f32_16x16x32_bf16(Bt[n][k], At[m][k], acc[ai][bj][m][n], 0, 0, 0); __builtin_amdgcn_s_setprio(0); } while (0)
#define PG8_WAIT_V(n) asm volatile("s_waitcnt vmcnt(" #n ")" ::: "memory")
#define PG8_WAIT_L(n) asm volatile("s_waitcnt lgkmcnt(" #n ")" ::: "memory")
#define PG8_BAR __builtin_amdgcn_s_barrier()
#define PG8_SCHED __builtin_amdgcn_sched_barrier(0)
    Unit cur, nxt; int ui = 0;
    if (!S.next(0, cur)) return;
    f32x4 acc[2][2][4][2];
#pragma unroll
    for (int a = 0; a < 2; ++a)
#pragma unroll
        for (int b = 0; b < 2; ++b)
#pragma unroll
            for (int m = 0; m < 4; ++m)
#pragma unroll
                for (int n = 0; n < 2; ++n) acc[a][b][m][n] = (f32x4){0.f, 0.f, 0.f, 0.f};
    bf16x8 At[4][2], B0[2][2], B1[2][2];
    const char* cA = (const char*)g.A + (size_t)cur.pm * tstep; const char* cB = (const char*)g.Bt + (size_t)cur.pn * tstep;
    S.a_ready(cur);
    if constexpr (SP2) {
        PG8_STAGE(PG8_SB(0, 0), cB, voffB); PG8_STAGE(PG8_SB(0, 1), cB + hstep, voffB); PG8_STAGE(PG8_SA(0, 0), cA, voffA); PG8_STAGE(PG8_SA(0, 1), cA + hstep, voffA);
        if (wr == 1) PG8_BAR;
        PG8_WAIT_V(2); PG8_BAR;
        PG8_STAGE(PG8_SB(1, 0), cB + kstep, voffB); PG8_STAGE(PG8_SA(1, 0), cA + kstep, voffA); PG8_STAGE(PG8_SB(1, 1), cB + hstep + kstep, voffB);
        PG8_WAIT_V(6); PG8_BAR;
    } else {
        PG8_STAGE(PG8_SB(0, 0), cB, voffB); PG8_STAGE(PG8_SA(0, 0), cA, voffA); PG8_STAGE(PG8_SB(0, 1), cB + hstep, voffB); PG8_STAGE(PG8_SA(0, 1), cA + hstep, voffA);
        if (wr == 1) PG8_BAR;
        PG8_WAIT_V(4); PG8_BAR;
        PG8_STAGE(PG8_SB(1, 0), cB + kstep, voffB); PG8_STAGE(PG8_SA(1, 0), cA + kstep, voffA); PG8_STAGE(PG8_SB(1, 1), cB + hstep + kstep, voffB);
        PG8_WAIT_V(6); PG8_BAR;
    }
    for (;;) {
        const bool has_next = S.next(ui + 1, nxt);
        const char* nA = has_next ? (const char*)g.A + (size_t)nxt.pm * tstep : cA; const char* nB = has_next ? (const char*)g.Bt + (size_t)nxt.pn * tstep : cB;
#pragma nounroll
        for (int t = 0; t < nt; t += 2) {
            const bool last = (t == nt - 2);
            const char* a1 = cA + (size_t)(t + 1) * kstep;
            const char* a2 = last ? nA : cA + (size_t)(t + 2) * kstep; const char* b2 = last ? nB : cB + (size_t)(t + 2) * kstep;
            const char* a3 = a2 + kstep; const char* b3 = b2 + kstep;
            if (last && has_next) S.a_ready(nxt);
            if constexpr (SP2) {
            PG8_LDB(B0, 0, 0); PG8_LDB(B1, 0, 1); PG8_SCHED; PG8_LDA(At, 0, 0); PG8_STAGE(PG8_SA(1, 1), a1 + hstep, voffA);
            PG8_WAIT_V(8); PG8_WAIT_L(0); PG8_BAR; PG8_MMA(0, 0, At, B0); PG8_MMA(0, 1, At, B1); PG8_BAR; PG8_SCHED;
            PG8_LDA(At, 0, 1); PG8_STAGE(PG8_SB(0, 0), b2, voffB); PG8_STAGE(PG8_SB(0, 1), b2 + hstep, voffB); PG8_STAGE(PG8_SA(0, 0), a2, voffA);
            PG8_WAIT_V(8); PG8_WAIT_L(0); PG8_BAR; PG8_MMA(1, 0, At, B0); PG8_MMA(1, 1, At, B1); PG8_BAR; PG8_SCHED;
            PG8_LDB(B0, 1, 0); PG8_LDB(B1, 1, 1); PG8_SCHED; PG8_LDA(At, 1, 0); PG8_STAGE(PG8_SA(0, 1), a2 + hstep, voffA);
            PG8_WAIT_V(8); PG8_WAIT_L(0); PG8_BAR; PG8_MMA(0, 0, At, B0); PG8_MMA(0, 1, At, B1); PG8_BAR; PG8_SCHED;
            PG8_LDA(At, 1, 1); PG8_STAGE(PG8_SB(1, 0), b3, voffB); PG8_STAGE(PG8_SB(1, 1), b3 + hstep, voffB); PG8_STAGE(PG8_SA(1, 0), a3, voffA);
            PG8_WAIT_V(8); PG8_WAIT_L(0); PG8_BAR; PG8_MMA(1, 0, At, B0); PG8_MMA(1, 1, At, B1); PG8_BAR; PG8_SCHED;
            } else {
            PG8_LDB(B0, 0, 0); PG8_SCHED; PG8_LDA(At, 0, 0); PG8_STAGE(PG8_SA(1, 1), a1 + hstep, voffA);
            PG8_WAIT_L(8); PG8_BAR; PG8_WAIT_L(0); PG8_MMA(0, 0, At, B0); PG8_BAR; PG8_SCHED;
            PG8_LDB(B1, 0, 1); PG8_STAGE(PG8_SB(0, 0), b2, voffB);
            PG8_BAR; PG8_WAIT_L(0); PG8_MMA(0, 1, At, B1); PG8_BAR;
            PG8_LDA(At, 0, 1); PG8_STAGE(PG8_SA(0, 0), a2, voffA);
            PG8_BAR; PG8_WAIT_L(0); PG8_MMA(1, 0, At, B0); PG8_BAR; PG8_SCHED;
            PG8_STAGE(PG8_SB(0, 1), b2 + hstep, voffB);
            PG8_WAIT_V(6); PG8_BAR; PG8_MMA(1, 1, At, B1); PG8_BAR;
            PG8_LDB(B0, 1, 0); PG8_SCHED; PG8_LDA(At, 1, 0); PG8_STAGE(PG8_SA(0, 1), a2 + hstep, voffA);
            PG8_WAIT_L(8); PG8_BAR; PG8_WAIT_L(0); PG8_MMA(0, 0, At, B0); PG8_BAR; PG8_SCHED;
            PG8_LDB(B1, 1, 1); PG8_STAGE(PG8_SB(1, 0), b3, voffB);
            PG8_BAR; PG8_WAIT_L(0); PG8_MMA(0, 1, At, B1); PG8_BAR;
            PG8_LDA(At, 1, 1); PG8_STAGE(PG8_SA(1, 0), a3, voffA);
            PG8_BAR; PG8_WAIT_L(0); PG8_MMA(1, 0, At, B0); PG8_BAR; PG8_SCHED;
            PG8_STAGE(PG8_SB(1, 1), b3 + hstep, voffB);
            PG8_WAIT_V(6); PG8_BAR; PG8_MMA(1, 1, At, B1); PG8_BAR;
            }
        }
        if constexpr (ALIGN_EPI) { if (wr == 0) PG8_BAR; }
        if constexpr (!Epi::AFTER_DRAIN) { E(acc, cur, wr, wc, fr, fq); S.done(cur); }
        if (!has_next) break;
#pragma unroll
        for (int a = 0; a < 2; ++a)
#pragma unroll
            for (int b = 0; b < 2; ++b)
#pragma unroll
                for (int m = 0; m < 4; ++m)
#pragma unroll
                    for (int n = 0; n < 2; ++n) acc[a][b][m][n] = (f32x4){0.f, 0.f, 0.f, 0.f};
        cur = nxt; cA = nA; cB = nB; ++ui;
        if constexpr (ALIGN_EPI) { if (wr == 1) PG8_BAR; }
    }
    PG8_WAIT_V(0);
    if constexpr (!ALIGN_EPI) { if (wr == 0) PG8_BAR; }
    PG8_BAR;
    if constexpr (Epi::AFTER_DRAIN) { E.fused(acc, cur, wr, wc, fr, fq, lds, wid, lane); S.done(cur); }
#undef PG8_SA
#undef PG8_SB
#undef PG8_STAGE
#undef PG8_LDA
#undef PG8_LDB
#undef PG8_MMA
#undef PG8_WAIT_V
#undef PG8_WAIT_L
#undef PG8_BAR
#undef PG8_SCHED
}
}
#ifndef REP_SCAN
#define REP_SCAN 1
#endif
#ifndef REP_ATTN
#define REP_ATTN 1
#endif
#ifndef REP_HELP
#define REP_HELP 1
#endif
#ifndef REP_P4
#define REP_P4 1
#endif
#ifndef REP_P1
#define REP_P1 1
#endif
#ifndef REP_P2
#define REP_P2 1
#endif
#ifndef REP_CHAIN
#define REP_CHAIN 1
#endif
#ifndef PG8_SP2
#define PG8_SP2 true
#endif
#ifndef PG8_ALIGN
#define PG8_ALIGN true
#endif
constexpr int NWAVES = 8;
constexpr int BATCH = 16, T = 4096, D = 1024, M = BATCH * T;
constexpr int INW = 2560, FF = 4096, NLORA = 1536, KLORA = 256;
constexpr int ZR0 = 768;
constexpr float RMS_EPS = 1e-6f, GN_EPS = 64e-5f;
constexpr size_t MiB = 1u << 20;
constexpr size_t WS_WIN = 2 * MiB, WS_WOUT = 8 * MiB, WS_WUP = 10 * MiB, WS_WDOWN = 18 * MiB, WS_BL = 26 * MiB, WS_LB = 27 * MiB;
constexpr size_t WS_MIX = 32 * MiB, WS_XN = 160 * MiB, WS_Z = 288 * MiB, WS_ALORA = 608 * MiB, WS_LORA = 640 * MiB, WS_H = 288 * MiB, WS_PB = 832 * MiB, WS_QB = 896 * MiB, WS_END = 960 * MiB;
constexpr int LDS_BYTES = 147456;

#define GAS __attribute__((address_space(1)))
#define LAS __attribute__((address_space(3)))
typedef unsigned short bf16;
typedef unsigned v4u __attribute__((ext_vector_type(4)));
typedef unsigned v2u __attribute__((ext_vector_type(2)));
typedef float f32x4 __attribute__((ext_vector_type(4)));
typedef float f32x2 __attribute__((ext_vector_type(2)));
typedef float f32x16 __attribute__((ext_vector_type(16)));
typedef short bf16x8 __attribute__((ext_vector_type(8)));
typedef short s16x4 __attribute__((ext_vector_type(4)));
#define LDS_WAIT() asm volatile("s_waitcnt lgkmcnt(0)" ::: "memory")
#define VM_WAIT() asm volatile("s_waitcnt vmcnt(0)" ::: "memory")
typedef __bf16 bf16x2_t __attribute__((ext_vector_type(2)));
__device__ __forceinline__ unsigned f2bf(float f) { return (unsigned)__builtin_bit_cast(unsigned short, (__bf16)f); }
__device__ __forceinline__ unsigned pk2(float lo, float hi) { const bf16x2_t v = __builtin_convertvector((f32x2){lo, hi}, bf16x2_t); return __builtin_bit_cast(unsigned, v); }
__device__ __forceinline__ float bf2f(unsigned short b) { return __builtin_bit_cast(float, (unsigned)b << 16); }
__device__ __forceinline__ float bflo(unsigned w) { return __builtin_bit_cast(float, w << 16); }
__device__ __forceinline__ float bfhi(unsigned w) { return __builtin_bit_cast(float, w & 0xffff0000u); }
__device__ __forceinline__ float wave_sum(float v) {
#pragma unroll
    for (int o = 1; o < 64; o <<= 1) v += __shfl_xor(v, o);
    return v;
}
template <int CTRL, int RM = 0xF> __device__ __forceinline__ float dppf(float v) { return __builtin_bit_cast(float, __builtin_amdgcn_update_dpp(0, __builtin_bit_cast(int, v), CTRL, RM, 0xF, true)); }
__device__ __forceinline__ float red16(float v) { v += dppf<0xB1>(v); v += dppf<0x4E>(v); v += dppf<0x141>(v); v += dppf<0x140>(v); return v; }
__device__ __forceinline__ float red4(float v) { v += dppf<0xB1>(v); v += dppf<0x4E>(v); return v; }
__device__ __forceinline__ float red8(float v) { v += dppf<0xB1>(v); v += dppf<0x4E>(v); v += dppf<0x141>(v); return v; }
__device__ __forceinline__ float wsum(float v) {
    v += dppf<0xB1>(v); v += dppf<0x4E>(v); v += dppf<0x141>(v); v += dppf<0x140>(v);
    v += dppf<0x142, 0xA>(v); v += dppf<0x143, 0xC>(v);
    return __builtin_bit_cast(float, __builtin_amdgcn_readlane(__builtin_bit_cast(int, v), 63));
}
__device__ __forceinline__ float sigmoidf_(float x) { return __builtin_amdgcn_rcpf(1.0f + __expf(-x)); }
#define WG_BAR_LDS() do { asm volatile("s_waitcnt lgkmcnt(0)" ::: "memory"); __builtin_amdgcn_s_barrier(); asm volatile("" ::: "memory"); } while (0)
__device__ __forceinline__ void wg_global_sync() { VM_WAIT(); __syncthreads(); __builtin_amdgcn_fence(__ATOMIC_ACQUIRE, "agent"); VM_WAIT(); }

struct Args { const float* in[20]; float* out; unsigned char* ws; };
#define RLX_AGENT __ATOMIC_RELAXED, __HIP_MEMORY_SCOPE_AGENT
#define XB_TMO      128
#define XB_XCNT(j)  (256  + 64 * (j))
#define XB_XSUB(j)  (1280 + 64 * (j))
#define XB_XGEN(j)  (2304 + 64 * (j))
#define XB_TOP      3328
#define XB_TOPGEN   3392
#define XCD_BAR_WORDS 3456
#define XB_SPIN_CAP (1u << 18)

__device__ __forceinline__ unsigned xb_ld(unsigned* p)              { return __hip_atomic_load(p, __ATOMIC_RELAXED, __HIP_MEMORY_SCOPE_AGENT); }
__device__ __forceinline__ unsigned xb_add(unsigned* p, unsigned v) { return __hip_atomic_fetch_add(p, v, __ATOMIC_RELAXED, __HIP_MEMORY_SCOPE_AGENT); }
__device__ __forceinline__ unsigned xb_xcc_id() { return (unsigned)__builtin_amdgcn_s_getreg((3 << 11) | 20) & 0xFu; }
#define XB_SPIN(cond, bar) do { unsigned _sp = 0; while (cond) { __builtin_amdgcn_s_sleep(1); \
    if ((++_sp & 255u) == 0u) { if (xb_ld(&(bar)[XB_TMO])) break; if (_sp > XB_SPIN_CAP) { atomicAdd(&(bar)[XB_TMO], 1u); break; } } } } while (0)

struct XcdBarrier {
    unsigned* bar; unsigned x;
    volatile LAS unsigned* st;
};

__device__ __forceinline__ XcdBarrier xcd_barrier_post(unsigned* bar, volatile LAS unsigned* st) {
    XcdBarrier b; b.bar = bar; b.x = xb_xcc_id(); b.st = st;
    if (threadIdx.x == 0) (void)xb_add(&bar[XB_XCNT(b.x)], 1u);
    return b;
}
__device__ __forceinline__ void xcd_barrier_complete(unsigned* bar, unsigned x, unsigned& nloc, unsigned& nx) {
    const unsigned G = gridDim.x * gridDim.y * gridDim.z;
    unsigned sum, cnt, mine, sp = 0u;
    for (;;) {
        sum = 0u; cnt = 0u; mine = 0u;
#pragma unroll
        for (unsigned j = 0; j < 16; ++j) { const unsigned c = xb_ld(&bar[XB_XCNT(j)]); sum += c; cnt += (c > 0u) ? 1u : 0u; mine = (j == x) ? c : mine; }
        if (sum == G) break;
        __builtin_amdgcn_s_sleep(1);
        if ((++sp & 255u) == 0u) { if (xb_ld(&bar[XB_TMO])) break; if (sp > XB_SPIN_CAP) { atomicAdd(&bar[XB_TMO], 1u); break; } }
    }
    nloc = mine > 0u ? mine : 1u; nx = cnt > 0u ? cnt : 1u;
}

__device__ __forceinline__ void xcd_barrier(const XcdBarrier& b) {
    asm volatile("s_waitcnt vmcnt(0)" ::: "memory");
    __syncthreads();
    if (threadIdx.x == 0) {
        unsigned* bar = b.bar;
        __builtin_amdgcn_s_waitcnt(0);
        unsigned nloc = b.st[0], nx = b.st[1];
        if (nloc == 0u) { xcd_barrier_complete(bar, b.x, nloc, nx); b.st[0] = nloc; b.st[1] = nx; }
        const unsigned old = xb_add(&bar[XB_XSUB(b.x)], 1u);
        const unsigned gen = old / nloc;
        if (old + 1u == (gen + 1u) * nloc) {
            __builtin_amdgcn_fence(__ATOMIC_RELEASE, "agent");
            asm volatile("s_waitcnt vmcnt(0)" ::: "memory");
            const unsigned og = xb_add(&bar[XB_TOP], 1u);
            const unsigned tg = og / nx;
            if (og + 1u == (tg + 1u) * nx) xb_add(&bar[XB_TOPGEN], 1u);
            else XB_SPIN(xb_ld(&bar[XB_TOPGEN]) == tg, bar);
            __builtin_amdgcn_fence(__ATOMIC_ACQUIRE, "agent");
            xb_add(&bar[XB_XGEN(b.x)], 1u);
            asm volatile("s_waitcnt vmcnt(0)" ::: "memory");
        } else {
            XB_SPIN(xb_ld(&bar[XB_XGEN(b.x)]) == gen, bar);
            __builtin_amdgcn_fence(__ATOMIC_ACQUIRE, "agent");
            asm volatile("s_waitcnt vmcnt(0)" ::: "memory");
        }
    }
    __syncthreads();
}

__device__ __forceinline__ void team_barrier(unsigned* cnt, unsigned np) {
    VM_WAIT(); __syncthreads();
    if (threadIdx.x == 0) {
        __builtin_amdgcn_fence(__ATOMIC_RELEASE, "agent"); VM_WAIT();
        __hip_atomic_fetch_add(cnt, 1u, __ATOMIC_RELAXED, __HIP_MEMORY_SCOPE_AGENT);
        unsigned sp = 0;
        while (__hip_atomic_load(cnt, __ATOMIC_RELAXED, __HIP_MEMORY_SCOPE_AGENT) < np) { __builtin_amdgcn_s_sleep(2); if (++sp > (1u << 22)) break; }
        __builtin_amdgcn_fence(__ATOMIC_ACQUIRE, "agent"); VM_WAIT();
    }
    __syncthreads();
}
__device__ __forceinline__ void p0_transpose_item(const float* W, int K, int N, bf16* WT, LAS float* scr, int item, int lane) {
    const int nblk = N / 32, kb = item / nblk, nb = item % nblk, k0 = 64 * kb, n0 = 32 * nb;
#pragma unroll 8
    for (int i = 0; i < 32; ++i) { const int kk = 2 * i + (lane >> 5); scr[kk * 33 + (lane & 31)] = W[(size_t)(k0 + kk) * N + n0 + (lane & 31)]; }
    LDS_WAIT(); asm volatile("" ::: "memory");
    const int c = lane & 7;
#pragma unroll
    for (int j = 0; j < 4; ++j) { const int n = (lane >> 3) + 8 * j; const LAS float* s = scr + (8 * c) * 33 + n;
        v4u o; o.x = pk2(s[0 * 33], s[1 * 33]); o.y = pk2(s[2 * 33], s[3 * 33]); o.z = pk2(s[4 * 33], s[5 * 33]); o.w = pk2(s[6 * 33], s[7 * 33]);
        *(GAS v4u*)(WT + (size_t)(n0 + n) * K + k0 + 8 * c) = o; }
    LDS_WAIT(); asm volatile("" ::: "memory");
}
template <int NR> __device__ __forceinline__ void rms_rows_to_bf16(const float* x0, size_t xstride, const float* g, bf16* o0, size_t ostride, int lane) {
    const GAS f32x4* gr = (const GAS f32x4*)g + lane;
    f32x4 v[NR][4]; float s[NR];
#pragma unroll
    for (int r = 0; r < NR; ++r) { const GAS f32x4* xr = (const GAS f32x4*)(x0 + r * xstride) + lane;
#pragma unroll
        for (int j = 0; j < 4; ++j) v[r][j] = xr[64 * j]; }
#pragma unroll
    for (int r = 0; r < NR; ++r) { float a = 0.f;
#pragma unroll
        for (int j = 0; j < 4; ++j) a += (v[r][j].x * v[r][j].x + v[r][j].y * v[r][j].y) + (v[r][j].z * v[r][j].z + v[r][j].w * v[r][j].w);
        s[r] = a; }
#pragma unroll
    for (int r = 0; r < NR; ++r) { const float rstd = __builtin_amdgcn_rsqf(wsum(s[r]) * (1.f / D) + RMS_EPS);
        GAS unsigned long long* o8 = (GAS unsigned long long*)(o0 + r * ostride) + lane;
#pragma unroll
        for (int j = 0; j < 4; ++j) { const f32x4 gg = gr[64 * j]; o8[64 * j] = (unsigned long long)pk2(v[r][j].x * rstd * gg.x, v[r][j].y * rstd * gg.y) | ((unsigned long long)pk2(v[r][j].z * rstd * gg.z, v[r][j].w * rstd * gg.w) << 32); } }
}
template <int NR> __device__ __forceinline__ void rms_rows_inplace(float* x0, size_t xstride, const float* g, int lane) {
    const GAS f32x4* gr = (const GAS f32x4*)g + lane;
    f32x4 v[NR][4]; float s[NR];
#pragma unroll
    for (int r = 0; r < NR; ++r) { const GAS f32x4* xr = (const GAS f32x4*)(x0 + r * xstride) + lane;
#pragma unroll
        for (int j = 0; j < 4; ++j) v[r][j] = xr[64 * j]; }
#pragma unroll
    for (int r = 0; r < NR; ++r) { float a = 0.f;
#pragma unroll
        for (int j = 0; j < 4; ++j) a += (v[r][j].x * v[r][j].x + v[r][j].y * v[r][j].y) + (v[r][j].z * v[r][j].z + v[r][j].w * v[r][j].w);
        s[r] = a; }
#pragma unroll
    for (int r = 0; r < NR; ++r) { const float rstd = __builtin_amdgcn_rsqf(wsum(s[r]) * (1.f / D) + RMS_EPS);
        GAS f32x4* xr = (GAS f32x4*)(x0 + r * xstride) + lane;
#pragma unroll
        for (int j = 0; j < 4; ++j) { const f32x4 gg = gr[64 * j]; xr[64 * j] = v[r][j] * rstd * gg; } }
}

__device__ __forceinline__ void lora_in_row(const bf16* Z, const float* mu, bf16* AL, int m, int lane) {
    const int c = 4 * lane;
    const v2u zc = *(const GAS v2u*)(Z + (size_t)m * INW + 2304 + c);
    const bool hasp = (m % T) != 0;
    const v2u zp = *(const GAS v2u*)(Z + (size_t)(hasp ? m - 1 : m) * INW + 2304 + c);
    const float fac = hasp ? 1.f : 0.f;
    const f32x4 mv = *(const GAS f32x4*)(mu + 1536 + c);
    float z[4] = {bflo(zc.x), bfhi(zc.x), bflo(zc.y), bfhi(zc.y)}, p[4] = {bflo(zp.x) * fac, bfhi(zp.x) * fac, bflo(zp.y) * fac, bfhi(zp.y) * fac}, o[4];
#pragma unroll
    for (int j = 0; j < 4; ++j) { const float v = z[j] + (p[j] - z[j]) * mv[j];
        o[j] = (c < 64) ? (1.f - 2.f / (1.f + __expf(2.f * v))) : ((c < 128) ? v : sigmoidf_(v)); }
    v2u w; w.x = pk2(o[0], o[1]); w.y = pk2(o[2], o[3]);
    *(GAS v2u*)(AL + (size_t)m * KLORA + c) = w;
}

constexpr int AT_KSTR = 144, AT_VSTR = 520, AT_VOFF = 256 * AT_KSTR;
__device__ __forceinline__ int crow(int r, int hi) { return (r & 3) + 8 * (r >> 2) + 4 * hi; }
__device__ __forceinline__ void attn_unit(LAS unsigned char* lds, const bf16* Z, bf16* MIX, const float* sinks, int b, int nb, int kvh) {
    const int tid = threadIdx.x, wid = __builtin_amdgcn_readfirstlane(tid >> 6), lane = tid & 63;
    __syncthreads();
#pragma unroll
    for (int i = 0; i < 4; ++i) {
        const int chunk = tid + 512 * i, key = chunk >> 3, c8 = chunk & 7, kpos = nb * 128 - 128 + key;
        v4u kv = (v4u){0u, 0u, 0u, 0u}, vv = (v4u){0u, 0u, 0u, 0u};
        if (kpos >= 0) { const bf16* zr = Z + (size_t)(b * T + kpos) * INW + 512 + kvh * 64 + c8 * 8; kv = *(const GAS v4u*)zr; vv = *(const GAS v4u*)(zr + 128); }
        *(LAS v4u*)(lds + key * AT_KSTR + c8 * 16) = kv;
        LAS unsigned short* vt = (LAS unsigned short*)(lds + AT_VOFF + (c8 * 8) * AT_VSTR + key * 2);
#pragma unroll
        for (int e = 0; e < 4; ++e) { vt[(2 * e) * (AT_VSTR / 2)] = (unsigned short)(vv[e] & 0xffffu); vt[(2 * e + 1) * (AT_VSTR / 2)] = (unsigned short)(vv[e] >> 16); }
    }
    __syncthreads();
    const int g = wid >> 1, hq = kvh * 4 + g, qhalf = wid & 1, q = lane & 31, hh = lane >> 5;
    const float slope = exp2f(-(float)(hq + 1)), sink = sinks[hq];
    for (int qt = 0; qt < 2; ++qt) {
        const int q0 = qhalf * 64 + qt * 32, qi = q0 + q, kt0 = q0 >> 5; const size_t m = (size_t)b * T + nb * 128 + qi;
        bf16x8 qf[4];
#pragma unroll
        for (int s = 0; s < 4; ++s) qf[s] = *(const GAS bf16x8*)(Z + m * INW + hq * 64 + 16 * s + 8 * hh);
        f32x16 sc[5];
#pragma unroll
        for (int i = 0; i < 5; ++i) {
#pragma unroll
            for (int r = 0; r < 16; ++r) sc[i][r] = 0.f;
#pragma unroll
            for (int s = 0; s < 4; ++s) { const bf16x8 a = *(const LAS bf16x8*)(lds + (32 * (kt0 + i) + q) * AT_KSTR + (16 * s + 8 * hh) * 2); sc[i] = __builtin_amdgcn_mfma_f32_32x32x16_bf16(a, qf[s], sc[i], 0, 0, 0); }
        }
        float mx = -1e30f;
#pragma unroll
        for (int i = 0; i < 5; ++i)
#pragma unroll
            for (int r = 0; r < 16; ++r) { const int kj = 32 * (kt0 + i) + crow(r, hh), dist = qi - kj + 128; const bool valid = (dist >= 0) && (dist < 128) && (nb * 128 - 128 + kj >= 0);
                const float v = valid ? (sc[i][r] * 0.125f - slope * (float)dist) : -1e30f; sc[i][r] = v; mx = fmaxf(mx, v); }
        mx = fmaxf(mx, __shfl_xor(mx, 32)); mx = fmaxf(mx, sink);
        float sum = 0.f;
#pragma unroll
        for (int i = 0; i < 5; ++i)
#pragma unroll
            for (int r = 0; r < 16; ++r) { const float e = __expf(sc[i][r] - mx); sc[i][r] = e; sum += e; }
        sum += __shfl_xor(sum, 32);
        const float inv = 1.0f / (sum + __expf(sink - mx));
        f32x16 o[2];
#pragma unroll
        for (int r = 0; r < 16; ++r) { o[0][r] = 0.f; o[1][r] = 0.f; }
#pragma unroll
        for (int i = 0; i < 5; ++i)
#pragma unroll
            for (int s = 0; s < 2; ++s) {
                v4u pw;
#pragma unroll
                for (int j = 0; j < 4; ++j) pw[j] = pk2(sc[i][8 * s + 2 * j] * inv, sc[i][8 * s + 2 * j + 1] * inv);
                const bf16x8 xs = __builtin_bit_cast(bf16x8, pw);
                const int kb = 32 * (kt0 + i) + 16 * s + 4 * hh;
#pragma unroll
                for (int dt = 0; dt < 2; ++dt) { const LAS unsigned char* vp = lds + AT_VOFF + (dt * 32 + q) * AT_VSTR + kb * 2;
                    const s16x4 lo = *(const LAS s16x4*)vp, hi = *(const LAS s16x4*)(vp + 16);
                    const bf16x8 pa = __builtin_shufflevector(lo, hi, 0, 1, 2, 3, 4, 5, 6, 7);
                    o[dt] = __builtin_amdgcn_mfma_f32_32x32x16_bf16(pa, xs, o[dt], 0, 0, 0); }
            }
        bf16* orow = MIX + m * D + hq * 64 + 4 * hh;
#pragma unroll
        for (int dt = 0; dt < 2; ++dt)
#pragma unroll
            for (int r4 = 0; r4 < 4; ++r4) { v2u w; w.x = pk2(o[dt][4 * r4], o[dt][4 * r4 + 1]); w.y = pk2(o[dt][4 * r4 + 2], o[dt][4 * r4 + 3]); *(GAS v2u*)(orow + dt * 32 + 8 * r4) = w; }
    }
}

constexpr int TC = 16, NCH = T / TC;
constexpr int SC_W = 0, SC_A = TC * 64, SC_B = 2 * TC * 64, SC_K = 3 * TC * 64, SC_R = 4 * TC * 64, SC_V = 5 * TC * 64, SC_G = 6 * TC * 64, SC_BON = 7 * TC * 64, SC_YP = 7 * TC * 64 + 64, SC_BUF = SC_YP + TC * 32 * 4;
static_assert(2 * SC_BUF * 4 <= 131072, "scan LDS");
struct ScanConst { f32x4 mu_r, mu_k, mu_v, kk, ka, rk; };
struct ScanRaw { v2u zr[3], zp[3], lo[3], lp; float fac, fac2; };
__device__ __forceinline__ f32x4 unpack4(v2u p) { return (f32x4){bflo(p.x), bfhi(p.x), bflo(p.y), bfhi(p.y)}; }
__device__ __forceinline__ float sum4(f32x4 v) { return (v.x + v.y) + (v.z + v.w); }
__device__ __forceinline__ void scan_load(ScanRaw& R, const bf16* Z, const bf16* LORA, int b, int h, int t0, int k4, int lane) {
    const int t = 4 * k4 + (lane >> 4), hc = h * 64 + 4 * (lane & 15); const size_t m = (size_t)b * T + t0 + t; const bool hasp = (t0 + t) > 0; R.fac = hasp ? 1.f : 0.f;
    const bool inchunk = t > 0; R.fac2 = inchunk ? 1.f : 0.f;
    const bf16* zrow = Z + m * INW + ZR0 + hc; const bf16* prow = hasp ? zrow - INW : zrow; const bf16* lrow = LORA + m * NLORA + hc;
#pragma unroll
    for (int j = 0; j < 3; ++j) { R.zr[j] = *(const GAS v2u*)(zrow + 512 * j); R.zp[j] = *(const GAS v2u*)(prow + 512 * j); R.lo[j] = *(const GAS v2u*)(lrow + 512 * j); }
    R.lp = *(const GAS v2u*)(inchunk ? lrow - NLORA : lrow);
}
__device__ __forceinline__ void scan_store(LAS float* buf, const ScanRaw& R, int k4, int lane, const ScanConst& c) {
    const int t = 4 * k4 + (lane >> 4), cg = lane & 15;
    const f32x4 zr = unpack4(R.zr[0]), zk = unpack4(R.zr[1]), zv = unpack4(R.zr[2]);
    const f32x4 xr = zr + (unpack4(R.zp[0]) * R.fac - zr) * c.mu_r, xk = zk + (unpack4(R.zp[1]) * R.fac - zk) * c.mu_k, xv = zv + (unpack4(R.zp[2]) * R.fac - zv) * c.mu_v;
    const f32x4 L = unpack4(R.lo[0]), Lp = unpack4(R.lp) * R.fac2, a = unpack4(R.lo[1]), g = unpack4(R.lo[2]);
    f32x4 eP, ePm, eN;
#pragma unroll
    for (int e = 0; e < 4; ++e) { eP[e] = __expf(L[e]); ePm[e] = __expf(Lp[e]); eN[e] = __builtin_amdgcn_rcpf(eP[e]); }
    const f32x4 kkr = xk * c.kk; const float ss = red16(sum4(kkr * kkr)); const f32x4 kk = kkr * __builtin_amdgcn_rsqf(fmaxf(ss, 1e-24f));
    const f32x4 k = xk * (1.f + (a - 1.f) * c.ka);
    const float bon = red16(sum4(xr * k * c.rk));
    *(LAS f32x4*)(buf + SC_A + t * 64 + 4 * cg) = -(kk * ePm); *(LAS f32x4*)(buf + SC_B + t * 64 + 4 * cg) = kk * a * eN; *(LAS f32x4*)(buf + SC_K + t * 64 + 4 * cg) = k * eN;
    *(LAS f32x4*)(buf + SC_R + t * 64 + 4 * cg) = xr * eP; *(LAS f32x4*)(buf + SC_V + t * 64 + 4 * cg) = xv; *(LAS f32x4*)(buf + SC_G + t * 64 + 4 * cg) = g; if (cg == 0) buf[SC_BON + t] = bon;
    if (t == TC - 1) *(LAS f32x4*)(buf + SC_W + 4 * cg) = eP;
}
__device__ __forceinline__ void scan_output(const LAS float* buf, float* Y, bf16* PB, bf16* QB, int b, int h, int half, int t0, int k4, int lane, f32x2 lnw2, f32x2 lnb2) {
    const int t = 4 * k4 + (lane >> 4), cg = lane & 15, row = half * 32 + 2 * cg; const size_t m = (size_t)b * T + t0 + t;
    const LAS f32x4* yp = (const LAS f32x4*)(buf + SC_YP + (t * 32 + 2 * cg) * 4);
    f32x2 y; y.x = sum4(yp[0]); y.y = sum4(yp[1]);
    const f32x2 v = *(const LAS f32x2*)(buf + SC_V + t * 64 + row), g = *(const LAS f32x2*)(buf + SC_G + t * 64 + row);
    const float bon = buf[SC_BON + t];
    const f32x2 P = g * lnw2, Q = (lnb2 + v * bon) * g;
    const size_t off = m * 512 + h * 64 + row;
    *(GAS f32x2*)(Y + off) = y; *(GAS unsigned*)(PB + off) = pk2(P.x, P.y); *(GAS unsigned*)(QB + off) = pk2(Q.x, Q.y);
}
struct ScanOps { f32x4 a, b, k, r; float v0, v1; };
__device__ __forceinline__ void scan_ops_load(ScanOps& o, const LAS float* buf, int t, int slice, int vrow) {
    o.a = *(const LAS f32x4*)(buf + SC_A + t * 64 + slice * 4); o.b = *(const LAS f32x4*)(buf + SC_B + t * 64 + slice * 4);
    o.k = *(const LAS f32x4*)(buf + SC_K + t * 64 + slice * 4); o.r = *(const LAS f32x4*)(buf + SC_R + t * 64 + slice * 4);
    o.v0 = buf[SC_V + t * 64 + vrow]; o.v1 = buf[SC_V + t * 64 + vrow + 16];
}
__device__ __forceinline__ void scan_steps(LAS float* buf, f32x2 (&S0)[2], f32x2 (&S1)[2], int slice, int rq, int vrow) {
    ScanOps cur; scan_ops_load(cur, buf, 0, slice, vrow);
    const f32x4 pc = *(const LAS f32x4*)(buf + SC_W + slice * 4);
    float yp0 = 0.f, yp1 = 0.f;
#pragma unroll
    for (int t = 0; t < TC; ++t) {
        ScanOps nxt; if (t + 1 < TC) scan_ops_load(nxt, buf, t + 1, slice, vrow);
        __builtin_amdgcn_sched_barrier(0);
        const f32x2 a[2] = {cur.a.xy, cur.a.zw}, bb[2] = {cur.b.xy, cur.b.zw}, k[2] = {cur.k.xy, cur.k.zw}, r[2] = {cur.r.xy, cur.r.zw};
        const f32x2 d0 = S0[0] * a[0] + S0[1] * a[1], d1 = S1[0] * a[0] + S1[1] * a[1];
        float e0 = d0.x + d0.y, e1 = d1.x + d1.y;
        e0 += dppf<0xB1>(e0); e1 += dppf<0xB1>(e1); yp0 += dppf<0xB1>(yp0); yp1 += dppf<0xB1>(yp1);
        e0 += dppf<0x4E>(e0); e1 += dppf<0x4E>(e1); yp0 += dppf<0x4E>(yp0); yp1 += dppf<0x4E>(yp1);
        e0 += dppf<0x141>(e0); e1 += dppf<0x141>(e1);
        if (t > 0) { buf[SC_YP + ((t - 1) * 32 + rq) * 4 + (slice >> 2)] = yp0; buf[SC_YP + ((t - 1) * 32 + rq + 16) * 4 + (slice >> 2)] = yp1; }
        e0 += dppf<0x140>(e0); e1 += dppf<0x140>(e1);
        const f32x2 sa0v = {e0, e0}, sa1v = {e1, e1}, v0v = {cur.v0, cur.v0}, v1v = {cur.v1, cur.v1};
#pragma unroll
        for (int q = 0; q < 2; ++q) { S0[q] = S0[q] + sa0v * bb[q] + v0v * k[q]; S1[q] = S1[q] + sa1v * bb[q] + v1v * k[q]; }
        const f32x2 y0 = S0[0] * r[0] + S0[1] * r[1], y1 = S1[0] * r[0] + S1[1] * r[1];
        yp0 = y0.x + y0.y; yp1 = y1.x + y1.y;
        __builtin_amdgcn_sched_barrier(0);
        if (t + 1 < TC) cur = nxt;
    }
    S0[0] *= pc.xy; S0[1] *= pc.zw; S1[0] *= pc.xy; S1[1] *= pc.zw;
    yp0 = red4(yp0); yp1 = red4(yp1);
    buf[SC_YP + ((TC - 1) * 32 + rq) * 4 + (slice >> 2)] = yp0; buf[SC_YP + ((TC - 1) * 32 + rq + 16) * 4 + (slice >> 2)] = yp1;
}
__device__ __forceinline__ void scan_unit(LAS float* lds, const bf16* Z, const bf16* LORA, float* Y, bf16* PB, bf16* QB, const Args& args, int b, int h, int half) {
    const int tid = threadIdx.x, wid = __builtin_amdgcn_readfirstlane(tid >> 6), lane = tid & 63;
    __syncthreads();
    if (wid < 4) {
        const int slice = tid & 15, rq = tid >> 4, vrow = half * 32 + rq;
        f32x2 S0[2], S1[2];
#pragma unroll
        for (int q = 0; q < 2; ++q) { S0[q] = (f32x2){0.f, 0.f}; S1[q] = (f32x2){0.f, 0.f}; }
        WG_BAR_LDS();
        for (int ch = 0; ch < NCH; ++ch) { scan_steps(lds + (ch & 1) * SC_BUF, S0, S1, slice, rq, vrow); WG_BAR_LDS(); }
    } else {
        const int k4 = wid - 4, hc4 = h * 64 + 4 * (lane & 15), row = h * 64 + half * 32 + 2 * (lane & 15);
        ScanConst c; c.mu_r = *(const GAS f32x4*)(args.in[4] + hc4); c.mu_k = *(const GAS f32x4*)(args.in[4] + 512 + hc4); c.mu_v = *(const GAS f32x4*)(args.in[4] + 1024 + hc4);
        c.kk = *(const GAS f32x4*)(args.in[10] + hc4); c.ka = *(const GAS f32x4*)(args.in[11] + hc4); c.rk = *(const GAS f32x4*)(args.in[12] + hc4);
        const f32x2 lnw2 = *(const GAS f32x2*)(args.in[13] + row), lnb2 = *(const GAS f32x2*)(args.in[14] + row);
        ScanRaw Re, Ro; scan_load(Re, Z, LORA, b, h, 0, k4, lane); scan_store(lds, Re, k4, lane, c); scan_load(Ro, Z, LORA, b, h, TC, k4, lane); scan_load(Re, Z, LORA, b, h, 2 * TC, k4, lane);
        WG_BAR_LDS();
        for (int ch = 0; ch < NCH; ch += 2) {
            {
                LAS float* oth = lds + SC_BUF;
                if (ch > 0) scan_output(oth, Y, PB, QB, b, h, half, (ch - 1) * TC, k4, lane, lnw2, lnb2);
                scan_store(oth, Ro, k4, lane, c);
                if (ch + 3 < NCH) scan_load(Ro, Z, LORA, b, h, (ch + 3) * TC, k4, lane);
                WG_BAR_LDS();
            }
            {
                LAS float* oth = lds;
                scan_output(oth, Y, PB, QB, b, h, half, ch * TC, k4, lane, lnw2, lnb2);
                if (ch + 2 < NCH) { scan_store(oth, Re, k4, lane, c); if (ch + 4 < NCH) scan_load(Re, Z, LORA, b, h, (ch + 4) * TC, k4, lane); }
                WG_BAR_LDS();
            }
        }
        scan_output(lds + ((NCH - 1) & 1) * SC_BUF, Y, PB, QB, b, h, half, (NCH - 1) * TC, k4, lane, lnw2, lnb2);
    }
    __syncthreads();
}
__device__ __forceinline__ void rwkv_post_panel(const float* Y, const bf16* PB, const bf16* QB, bf16* MIX, int pm, int wave, int lane) {
    const int tsub = lane >> 4, cg = lane & 15;
    for (int j0 = 0; j0 < 64; j0 += 4) {
        f32x4 y[4]; v2u p[4], q[4];
#pragma unroll
        for (int u = 0; u < 4; ++u) { const size_t off = (size_t)(pm * 256 + (j0 + u) * 4 + tsub) * 512 + wave * 64 + 4 * cg; y[u] = *(const GAS f32x4*)(Y + off); p[u] = *(const GAS v2u*)(PB + off); q[u] = *(const GAS v2u*)(QB + off); }
#pragma unroll
        for (int u = 0; u < 4; ++u) { const size_t m = (size_t)(pm * 256 + (j0 + u) * 4 + tsub);
            const float mean = red16(sum4(y[u])) * (1.f / 64.f); const f32x4 d = y[u] - mean; const float var = red16(sum4(d * d)) * (1.f / 64.f);
            const f32x4 o = d * __builtin_amdgcn_rsqf(var + GN_EPS) * unpack4(p[u]) + unpack4(q[u]);
            v2u pw; pw.x = pk2(o[0], o[1]); pw.y = pk2(o[2], o[3]);
            *(GAS v2u*)(MIX + m * D + 512 + wave * 64 + 4 * cg) = pw; }
    }
}

__global__ void __launch_bounds__(NWAVES * 64, 2) mk_fwd(Args args) {
    extern __shared__ __attribute__((aligned(16))) unsigned char lds_raw[];
    LAS unsigned char* lds = (LAS unsigned char*)lds_raw;
    cg::grid_group grid = cg::this_grid();
    volatile LAS unsigned* bar_st = (volatile LAS unsigned*)(lds + 131072 + 64);
    if (threadIdx.x == 0) { bar_st[0] = 0u; bar_st[1] = 0u; }
    __syncthreads();
    const int tid = threadIdx.x, lane = tid & 63, wave = __builtin_amdgcn_readfirstlane(tid >> 6);
    const int G = gridDim.x, bx = blockIdx.x;
    unsigned char* ws = args.ws;
    const float* x = args.in[0]; float* out = args.out;
    bf16* WIN = (bf16*)(ws + WS_WIN); bf16* WOUT = (bf16*)(ws + WS_WOUT); bf16* WUP = (bf16*)(ws + WS_WUP); bf16* WDOWN = (bf16*)(ws + WS_WDOWN); bf16* BL = (bf16*)(ws + WS_BL); float* LB = (float*)(ws + WS_LB);
    bf16* MIX = (bf16*)(ws + WS_MIX); float* Yb = (float*)(ws + WS_XN); bf16* PB = (bf16*)(ws + WS_PB); bf16* QB = (bf16*)(ws + WS_QB); bf16* XN = (bf16*)(ws + WS_XN); bf16* Zb = (bf16*)(ws + WS_Z); bf16* AL = (bf16*)(ws + WS_ALORA); bf16* LORA = (bf16*)(ws + WS_LORA); bf16* HB = (bf16*)(ws + WS_H);

    {
        LAS float* scr = (LAS float*)(lds + wave * 16384);
        const int gw = bx * NWAVES + wave, NGW = G * NWAVES;
        constexpr int I_IN = (D / 64) * (INW / 32), I_OUT = (D / 64) * (D / 32), I_UP = (D / 64) * (FF / 32), I_DN = (FF / 64) * (D / 32);
        constexpr int NITEMS = I_IN + I_OUT + I_UP + I_DN;
        for (int it = gw; it < NITEMS; it += NGW) {
            int r = it;
            if (r < I_IN) { p0_transpose_item(args.in[2], D, INW, WIN, scr, r, lane); continue; } r -= I_IN;
            if (r < I_OUT) { p0_transpose_item(args.in[15], D, D, WOUT, scr, r, lane); continue; } r -= I_OUT;
            if (r < I_UP) { p0_transpose_item(args.in[17], D, FF, WUP, scr, r, lane); continue; } r -= I_UP;
            p0_transpose_item(args.in[18], FF, D, WDOWN, scr, r, lane);
        }
        if (bx == 0) for (int i = tid; i < 32768; i += NWAVES * 64) ((unsigned*)ws)[i] = 0u;
        for (int idx = bx * (NWAVES * 64) + tid; idx < NLORA * KLORA; idx += G * NWAVES * 64) {
            const int n = idx / KLORA, k = idx % KLORA; float v = 0.f;
            if (n < 512) { if (k < 64) v = args.in[6][k * 512 + n]; }
            else if (n < 1024) { if (k >= 64 && k < 128) v = args.in[8][(k - 64) * 512 + (n - 512)]; }
            else { if (k >= 128) v = args.in[9][(k - 128) * 512 + (n - 1024)]; }
            BL[idx] = (bf16)f2bf(v);
        }
        for (int idx = bx * (NWAVES * 64) + tid; idx < NLORA; idx += G * NWAVES * 64) LB[idx] = idx < 512 ? args.in[5][idx] : (idx < 1024 ? args.in[7][idx - 512] : 0.f);
        for (int m = gw * 4; m < M; m += NGW * 4) rms_rows_to_bf16<4>(x + (size_t)m * D, D, args.in[1], XN + (size_t)m * D, D, lane);
    }
    grid.sync();
    const XcdBarrier xbar = xcd_barrier_post((unsigned*)ws + 16384, bar_st);
    for (int rep_ = 0; rep_ < REP_P1; ++rep_) {
        pg8::Gemm g{XN, WIN, M, INW, D};
        const int pr = (bx >> 3) & 1, pbase = (bx & ~8);
        pg8::TeamOrder S{pbase, 8, pr * 5, 2, 5};
        pg8::EpiBf16<0> E{Zb, INW, nullptr, 0, 0, 1.f};
        pg8::gemm_phase<pg8::EpiBf16<0>, pg8::TeamOrder, PG8_ALIGN, PG8_SP2>(lds, g, S, E);
    }
    xcd_barrier(xbar);
    if (bx < M / 256) { const int pm = bx;
        for (int r = wave * 4; r < 256; r += NWAVES * 4) {
#pragma unroll
            for (int q = 0; q < 4; ++q) lora_in_row(Zb, args.in[4], AL, pm * 256 + r + q, lane); }
        wg_global_sync();
        pg8::Gemm g{AL, BL, M, NLORA, KLORA}; pg8::PanelOrder S{pm, NLORA / 256};
        pg8::EpiBf16<3> E{LORA, NLORA, LB, 0, 0, 1.f};
#ifndef NO_P1B
        pg8::gemm_phase<pg8::EpiBf16<3>, pg8::PanelOrder, PG8_ALIGN, PG8_SP2>(lds, g, S, E);
#endif
    }
    xcd_barrier(xbar);
    {
        for (int u = bx; u < BATCH * 32 * 2; u += G) attn_unit(lds, Zb, MIX, args.in[3], u >> 6, (u >> 1) & 31, u & 1);
        for (int u = bx; u < BATCH * 16; u += G) scan_unit((LAS float*)lds, Zb, LORA, Yb, PB, QB, args, u >> 4, (u >> 1) & 7, u & 1);
    }
    xcd_barrier(xbar);
    if (bx < M / 256) { const int pm = bx;
        const int xq = bx & 7, role = (bx >> 3) & 3, q = bx >> 5, tp0 = q * 32 + xq; unsigned* tcnt = (unsigned*)ws + (size_t)(q * 8 + xq) * 256;
        rwkv_post_panel(Yb, PB, QB, MIX, pm, wave, lane);
        team_barrier(tcnt, 4u);
        { pg8::Gemm g{MIX, WOUT, M, D, D}; pg8::TeamOrder S{tp0, 8, role, 4, 1}; pg8::EpiResF32 E{x, out, D};
          pg8::gemm_phase<pg8::EpiResF32, pg8::TeamOrder, PG8_ALIGN, PG8_SP2>(lds, g, S, E); }
        team_barrier(tcnt + 32, 4u);
        for (int r = wave * 4; r < 256; r += NWAVES * 4) rms_rows_to_bf16<4>(out + (size_t)(pm * 256 + r) * D, D, args.in[16], XN + (size_t)(pm * 256 + r) * D, D, lane);
        team_barrier(tcnt + 64, 4u);
        { pg8::Gemm g{XN, WUP, M, FF, D}; pg8::TeamOrder S{tp0, 8, role * 4, 4, 4}; pg8::EpiBf16<2> E{HB, FF, nullptr, 0, 0, 1.f};
          pg8::gemm_phase<pg8::EpiBf16<2>, pg8::TeamOrder, PG8_ALIGN, PG8_SP2>(lds, g, S, E); }
        team_barrier(tcnt + 96, 4u);
        { pg8::Gemm g{HB, WDOWN, M, D, FF}; pg8::TeamOrder S{tp0, 8, role, 4, 1}; pg8::EpiResF32 E{out, out, D};
          pg8::gemm_phase<pg8::EpiResF32, pg8::TeamOrder, PG8_ALIGN, PG8_SP2>(lds, g, S, E); }
        team_barrier(tcnt + 128, 4u);
        for (int r = wave * 4; r < 256; r += NWAVES * 4) rms_rows_inplace<4>(out + (size_t)(pm * 256 + r) * D, D, args.in[19], lane);
    }
}

extern "C" void kernel_launch(void* const* d_in, const int* in_sizes, int n_in, void* d_out, int out_size, void* d_ws, size_t ws_size, hipStream_t stream) {
    static int grid = 0;
    if (grid == 0) {
        if (n_in != 20 || in_sizes[0] != M * D || out_size != M * D || ws_size < WS_END) { fprintf(stderr, "kernel_launch: unexpected shapes (n_in %d, in0 %d, out %d, ws %zu)\n", n_in, n_in > 0 ? in_sizes[0] : -1, out_size, ws_size); grid = -1; return; }
        int dev = 0, cus = 0, per_cu = 0;
        if (hipGetDevice(&dev) != hipSuccess || hipDeviceGetAttribute(&cus, hipDeviceAttributeMultiprocessorCount, dev) != hipSuccess) { grid = -1; return; }
        if (hipFuncSetAttribute((const void*)mk_fwd, hipFuncAttributeMaxDynamicSharedMemorySize, LDS_BYTES) != hipSuccess) { fprintf(stderr, "kernel_launch: hipFuncSetAttribute failed\n"); grid = -1; return; }
        if (hipOccupancyMaxActiveBlocksPerMultiprocessor(&per_cu, (const void*)mk_fwd, NWAVES * 64, LDS_BYTES) != hipSuccess || per_cu < 1) { fprintf(stderr, "kernel_launch: occupancy query says %d\n", per_cu); (void)hipGetLastError(); per_cu = 1; }
        if (cus < M / 256) { fprintf(stderr, "kernel_launch: needs >= 256 CUs\n"); grid = -1; return; }
        grid = M / 256;
    }
    if (grid < 0) return;
    Args a{};
    for (int i = 0; i < 20; ++i) a.in[i] = (const float*)d_in[i];
    a.out = (float*)d_out; a.ws = (unsigned char*)d_ws;
    void* kargs[] = {&a};
    hipError_t e = hipLaunchCooperativeKernel((const void*)mk_fwd, dim3(grid), dim3(NWAVES * 64), kargs, LDS_BYTES, stream);
    if (e != hipSuccess) fprintf(stderr, "kernel_launch: cooperative launch failed: %s (grid %d)\n", hipGetErrorString(e), grid);
}
```

```cpp
#include <hip/hip_runtime.h>
#include <hip/hip_cooperative_groups.h>
#include <cstdio>
#include <cstdint>
namespace cg = cooperative_groups;
namespace pg8 {
#define PG8_LAS __attribute__((address_space(3)))
typedef unsigned short bf16_t;
typedef short bf16x8 __attribute__((ext_vector_type(8)));
typedef float f32x4 __attribute__((ext_vector_type(4)));
typedef unsigned u32x4 __attribute__((ext_vector_type(4)));
constexpr int BM = 256, BK = 64, HALF = 128, HTB = HALF * BK * 2  , STAGE_BYTES = 8 * HTB, NXCD = 8, WGM = 8;

__host__ __device__ __forceinline__ int lds_byte(int r, int c) { const int st = (r >> 4) * 2 + (c >> 5), rr = r & 15, cc = c & 31, ob = rr * 64 + cc * 2; return st * 1024 + (ob ^ (((ob >> 9) & 1) << 5)); }
__host__ __device__ __forceinline__ void stage_rc(int b, int& R, int& C) { const int st = b / 1024, sb = b % 1024, swz = sb ^ (((sb >> 9) & 1) << 5); R = (st >> 1) * 16 + swz / 64; C = (st & 1) * 32 + (swz % 64) / 2; }
__host__ __device__ __forceinline__ int perm32(int rho) { const int n = rho >> 4, i = rho & 15; return 8 * (i >> 2) + 4 * n + (i & 3); }

struct Unit { int pm, pn; };
struct Gemm { const bf16_t* A; const bf16_t* Bt; int M, N, K; };

struct StaticOrder {
    int nM, nN, nwg, G, c;
    __host__ __device__ void init(int M, int N, int G_, int c_) { nM = M / BM; nN = N / BM; nwg = nM * nN; G = G_; c = c_; }
    __host__ __device__ bool next(int i, Unit& u) const {
        const long L = (long)i * G + c; if (L >= nwg) return false;
        int wgid = (int)L; { const int q = nwg / NXCD, r = nwg % NXCD, xcd = wgid % NXCD, off = wgid / NXCD; wgid = (xcd < r ? xcd * (q + 1) : r * (q + 1) + (xcd - r) * q) + off; }
        const int nig = WGM * nN, gid = wgid / nig, fm = gid * WGM, gsz = (nM - fm) < WGM ? (nM - fm) : WGM;
        u.pm = fm + ((wgid % nig) % gsz); u.pn = (wgid % nig) / gsz; return true;
    }
    __device__ __forceinline__ void a_ready(const Unit&) const {}
    __device__ __forceinline__ void done(const Unit&) const {}
};

__device__ __forceinline__ unsigned cvt_pk_bf16(float lo, float hi) { unsigned r; asm volatile("v_cvt_pk_bf16_f32 %0, %1, %2" : "=v"(r) : "v"(lo), "v"(hi)); return r; }
template <int N> __device__ __forceinline__ float row_shr_add(float x) { return x + __builtin_bit_cast(float, __builtin_amdgcn_update_dpp(0, __builtin_bit_cast(int, x), 0x110 + N, 0xF, 0xF, true)); }
__device__ __forceinline__ float row_prefix16(float x) { x = row_shr_add<1>(x); x = row_shr_add<2>(x); x = row_shr_add<4>(x); x = row_shr_add<8>(x); return x; }
template <int ACT  > struct EpiBf16 {
    static constexpr bool PERM = true, AFTER_DRAIN = false; static_assert(ACT == 0 || ACT == 2 || ACT == 3, "EpiBf16: ACT is 0 (none), 2 (relu squared) or 3 (RWKV LoRA heads: column tiles 0-1 cumulative log-decay per 16-row chunk, 2-3 sigmoid, 4-5 identity)");
    bf16_t* O; int ldc; const float* bias; int split_cols; size_t split_stride; float scale0;
    __device__ __forceinline__ void operator()(const f32x4 (&acc)[2][2][4][2], const Unit& u, int wr, int wc, int fr, int fq) const {
        const int row0 = u.pm * BM + wr * 64 + fr; int colt = u.pn * BM; bf16_t* base = O;
        float sc = 1.f; if (split_cols) { const int t = colt / split_cols; base += (size_t)t * split_stride; colt -= t * split_cols; if (t == 0) sc = scale0; }
        const int col0 = colt + wc * 32 + 8 * fq, bcol0 = u.pn * BM + wc * 32 + 8 * fq;
        f32x4 bv[2][2];
#pragma unroll
        for (int bj = 0; bj < 2; ++bj)
#pragma unroll
            for (int n = 0; n < 2; ++n) bv[bj][n] = bias ? *(const f32x4*)(bias + bcol0 + bj * HALF + 4 * n) : (f32x4){0.f, 0.f, 0.f, 0.f};
#pragma unroll
        for (int ai = 0; ai < 2; ++ai)
#pragma unroll
            for (int m = 0; m < 4; ++m) { bf16_t* rowp = base + (size_t)(row0 + ai * HALF + m * 16) * ldc + col0;
#pragma unroll
                for (int bj = 0; bj < 2; ++bj) { f32x4 v0 = acc[ai][bj][m][0] + bv[bj][0], v1 = acc[ai][bj][m][1] + bv[bj][1];
                    if (ACT == 3) { if (u.pn < 4) { const float sc3 = u.pn < 2 ? -0.60653066f : 1.0f;
#pragma unroll
                        for (int e = 0; e < 4; ++e) { v0[e] = sc3 * __builtin_amdgcn_rcpf(1.0f + __expf(-v0[e])); v1[e] = sc3 * __builtin_amdgcn_rcpf(1.0f + __expf(-v1[e])); }
                        if (u.pn < 2) {
#pragma unroll
                            for (int e = 0; e < 4; ++e) { v0[e] = row_prefix16(v0[e]); v1[e] = row_prefix16(v1[e]); } } } }
                    if (ACT == 2) { v0 = __builtin_elementwise_max(v0, (f32x4){0.f, 0.f, 0.f, 0.f}); v1 = __builtin_elementwise_max(v1, (f32x4){0.f, 0.f, 0.f, 0.f}); v0 = v0 * v0; v1 = v1 * v1; }
                    v0 = v0 * sc; v1 = v1 * sc; u32x4 w; w.x = cvt_pk_bf16(v0[0], v0[1]); w.y = cvt_pk_bf16(v0[2], v0[3]); w.z = cvt_pk_bf16(v1[0], v1[1]); w.w = cvt_pk_bf16(v1[2], v1[3]);
                    *(u32x4*)(rowp + bj * HALF) = w; } }
    }
};
struct EpiResF32 {
    static constexpr bool PERM = false, AFTER_DRAIN = false;
    const float* base; float* out; int ldc;
    __device__ __forceinline__ void operator()(const f32x4 (&acc)[2][2][4][2], const Unit& u, int wr, int wc, int fr, int fq) const {
        const int col0 = u.pn * BM + wc * 32 + 4 * fq;
#pragma unroll
        for (int ai = 0; ai < 2; ++ai)
#pragma unroll
            for (int m = 0; m < 4; ++m) { const int r = ai * HALF + wr * 64 + m * 16 + fr; const size_t off = (size_t)(u.pm * BM + r) * ldc + col0;
#pragma unroll
                for (int bj = 0; bj < 2; ++bj)
#pragma unroll
                    for (int n = 0; n < 2; ++n) { const f32x4 bs = *(const f32x4*)(base + off + bj * HALF + n * 16); const f32x4 o = bs + acc[ai][bj][m][n]; *(f32x4*)(out + off + bj * HALF + n * 16) = o; }
                if (m & 1) asm volatile("" ::: "memory"); }
    }
};
struct PanelOrder {
    int pm, nN;
    __device__ __forceinline__ bool next(int i, Unit& u) const { if (i >= nN) return false; u.pm = pm; u.pn = i; return true; }
    __device__ __forceinline__ void a_ready(const Unit&) const {}
    __device__ __forceinline__ void done(const Unit&) const {}
};
struct TeamOrder {
    int pm0, pstride, pn0, np, nt;
    __device__ __forceinline__ bool next(int i, Unit& u) const { if (i >= np * nt) return false; u.pm = pm0 + (i / nt) * pstride; u.pn = pn0 + (i % nt); return true; }
    __device__ __forceinline__ void a_ready(const Unit&) const {}
    __device__ __forceinline__ void done(const Unit&) const {}
};
template <class Epi, class Sched, bool ALIGN_EPI = false, bool SP2 = false>
__device__ __forceinline__ void gemm_phase(PG8_LAS unsigned char* lds, const Gemm g, const Sched& S, const Epi& E) {
    int tid_ = threadIdx.x; asm volatile("" : "+v"(tid_));
    const int tid = tid_, wid = __builtin_amdgcn_readfirstlane(tid >> 6), lane = tid & 63, wr = wid >> 2, wc = wid & 3, fr = lane & 15, fq = lane >> 4;
    const int K = g.K, nt = K / BK;
    unsigned voffA[2], voffB[2];
#pragma unroll
    for (int i = 0; i < 2; ++i) { int R, C; stage_rc(tid * 16 + i * 8192, R, C); const int Rb = Epi::PERM ? ((R & ~31) + perm32(R & 31)) : R;
        voffA[i] = (unsigned)(R * K + C) * 2u; voffB[i] = (unsigned)(Rb * K + C) * 2u; }
    const size_t kstep = (size_t)(BK * 2);
    const size_t hstep = (size_t)HALF * K * 2;
    const size_t tstep = 2 * hstep;
    const unsigned ldsw = (unsigned)wid * 1024u;
    const int aoff = lds_byte(wr * 64 + fr, fq * 8), boff = lds_byte(wc * 32 + fr, fq * 8);
#define PG8_SA(b, h) (((b) * 2 + (h)) * HTB)
#define PG8_SB(b, h) ((4 + (b) * 2 + (h)) * HTB)
#define PG8_STAGE(bufoff, gbase, voff) do { _Pragma("unroll") for (int _i = 0; _i < 2; ++_i) \
        __builtin_amdgcn_global_load_lds((const unsigned*)((const char*)(gbase) + (voff)[_i]), (PG8_LAS unsigned*)(lds + (bufoff) + ldsw + _i * 8192), 16, 0, 0); } while (0)
#define PG8_LDA(dst, b, h) do { _Pragma("unroll") for (int m = 0; m < 4; ++m) _Pragma("unroll") for (int k = 0; k < 2; ++k) dst[m][k] = *(const PG8_LAS bf16x8*)(lds + PG8_SA(b, h) + aoff + m * 2048 + k * 1024); } while (0)
#define PG8_LDB(dst, b, h) do { _Pragma("unroll") for (int n = 0; n < 2; ++n) _Pragma("unroll") for (int k = 0; k < 2; ++k) dst[n][k] = *(const PG8_LAS bf16x8*)(lds + PG8_SB(b, h) + boff + n * 2048 + k * 1024); } while (0)
#define PG8_MMA(ai, bj, At, Bt) do { __builtin_amdgcn_s_setprio(1); _Pragma("unroll") for (int m = 0; m < 4; ++m) _Pragma("unroll") for (int n = 0; n < 2; ++n) _Pragma("unroll") for (int k = 0; k < 2; ++k) \
        acc[ai][bj][m][n] = __builtin_amdgcn_mfma_f32_16x16x32_bf16(Bt[n][k], At[m][k], acc[ai][bj][m][n], 0, 0, 0); __builtin_amdgcn_s_setprio(0); } while (0)
#define PG8_WAIT_V(n) asm volatile("s_waitcnt vmcnt(" #n ")" ::: "memory")
#define PG8_WAIT_L(n) asm volatile("s_waitcnt lgkmcnt(" #n ")" ::: "memory")
#define PG8_BAR __builtin_amdgcn_s_barrier()
#define PG8_SCHED __builtin_amdgcn_sched_barrier(0)
    Unit cur, nxt; int ui = 0;
    if (!S.next(0, cur)) return;
    f32x4 acc[2][2][4][2];
#pragma unroll
    for (int a = 0; a < 2; ++a)
#pragma unroll
        for (int b = 0; b < 2; ++b)
#pragma unroll
            for (int m = 0; m < 4; ++m)
#pragma unroll
                for (int n = 0; n < 2; ++n) acc[a][b][m][n] = (f32x4){0.f, 0.f, 0.f, 0.f};
    bf16x8 At[4][2], B0[2][2], B1[2][2];
    const char* cA = (const char*)g.A + (size_t)cur.pm * tstep; const char* cB = (const char*)g.Bt + (size_t)cur.pn * tstep;
    S.a_ready(cur);
    if constexpr (SP2) {
        PG8_STAGE(PG8_SB(0, 0), cB, voffB); PG8_STAGE(PG8_SB(0, 1), cB + hstep, voffB); PG8_STAGE(PG8_SA(0, 0), cA, voffA); PG8_STAGE(PG8_SA(0, 1), cA + hstep, voffA);
        if (wr == 1) PG8_BAR;
        PG8_WAIT_V(2); PG8_BAR;
        PG8_STAGE(PG8_SB(1, 0), cB + kstep, voffB); PG8_STAGE(PG8_SA(1, 0), cA + kstep, voffA); PG8_STAGE(PG8_SB(1, 1), cB + hstep + kstep, voffB);
        PG8_WAIT_V(6); PG8_BAR;
    } else {
        PG8_STAGE(PG8_SB(0, 0), cB, voffB); PG8_STAGE(PG8_SA(0, 0), cA, voffA); PG8_STAGE(PG8_SB(0, 1), cB + hstep, voffB); PG8_STAGE(PG8_SA(0, 1), cA + hstep, voffA);
        if (wr == 1) PG8_BAR;
        PG8_WAIT_V(4); PG8_BAR;
        PG8_STAGE(PG8_SB(1, 0), cB + kstep, voffB); PG8_STAGE(PG8_SA(1, 0), cA + kstep, voffA); PG8_STAGE(PG8_SB(1, 1), cB + hstep + kstep, voffB);
        PG8_WAIT_V(6); PG8_BAR;
    }
    for (;;) {
        const bool has_next = S.next(ui + 1, nxt);
        const char* nA = has_next ? (const char*)g.A + (size_t)nxt.pm * tstep : cA; const char* nB = has_next ? (const char*)g.Bt + (size_t)nxt.pn * tstep : cB;
#pragma nounroll
        for (int t = 0; t < nt; t += 2) {
            const bool last = (t == nt - 2);
            const char* a1 = cA + (size_t)(t + 1) * kstep;
            const char* a2 = last ? nA : cA + (size_t)(t + 2) * kstep; const char* b2 = last ? nB : cB + (size_t)(t + 2) * kstep;
            const char* a3 = a2 + kstep; const char* b3 = b2 + kstep;
            if (last && has_next) S.a_ready(nxt);
            if constexpr (SP2) {
            PG8_LDB(B0, 0, 0); PG8_LDB(B1, 0, 1); PG8_SCHED; PG8_LDA(At, 0, 0); PG8_STAGE(PG8_SA(1, 1), a1 + hstep, voffA);
            PG8_WAIT_V(8); PG8_WAIT_L(0); PG8_BAR; PG8_MMA(0, 0, At, B0); PG8_MMA(0, 1, At, B1); PG8_BAR; PG8_SCHED;
            PG8_LDA(At, 0, 1); PG8_STAGE(PG8_SB(0, 0), b2, voffB); PG8_STAGE(PG8_SB(0, 1), b2 + hstep, voffB); PG8_STAGE(PG8_SA(0, 0), a2, voffA);
            PG8_WAIT_V(8); PG8_WAIT_L(0); PG8_BAR; PG8_MMA(1, 0, At, B0); PG8_MMA(1, 1, At, B1); PG8_BAR; PG8_SCHED;
            PG8_LDB(B0, 1, 0); PG8_LDB(B1, 1, 1); PG8_SCHED; PG8_LDA(At, 1, 0); PG8_STAGE(PG8_SA(0, 1), a2 + hstep, voffA);
            PG8_WAIT_V(8); PG8_WAIT_L(0); PG8_BAR; PG8_MMA(0, 0, At, B0); PG8_MMA(0, 1, At, B1); PG8_BAR; PG8_SCHED;
            PG8_LDA(At, 1, 1); PG8_STAGE(PG8_SB(1, 0), b3, voffB); PG8_STAGE(PG8_SB(1, 1), b3 + hstep, voffB); PG8_STAGE(PG8_SA(1, 0), a3, voffA);
            PG8_WAIT_V(8); PG8_WAIT_L(0); PG8_BAR; PG8_MMA(1, 0, At, B0); PG8_MMA(1, 1, At, B1); PG8_BAR; PG8_SCHED;
            } else {
            PG8_LDB(B0, 0, 0); PG8_SCHED; PG8_LDA(At, 0, 0); PG8_STAGE(PG8_SA(1, 1), a1 + hstep, voffA);
            PG8_WAIT_L(8); PG8_BAR; PG8_WAIT_L(0); PG8_MMA(0, 0, At, B0); PG8_BAR; PG8_SCHED;
            PG8_LDB(B1, 0, 1); PG8_STAGE(PG8_SB(0, 0), b2, voffB);
            PG8_BAR; PG8_WAIT_L(0); PG8_MMA(0, 1, At, B1); PG8_BAR;
            PG8_LDA(At, 0, 1); PG8_STAGE(PG8_SA(0, 0), a2, voffA);
            PG8_BAR; PG8_WAIT_L(0); PG8_MMA(1, 0, At, B0); PG8_BAR; PG8_SCHED;
            PG8_STAGE(PG8_SB(0, 1), b2 + hstep, voffB);
            PG8_WAIT_V(6); PG8_BAR; PG8_MMA(1, 1, At, B1); PG8_BAR;
            PG8_LDB(B0, 1, 0); PG8_SCHED; PG8_LDA(At, 1, 0); PG8_STAGE(PG8_SA(0, 1), a2 + hstep, voffA);
            PG8_WAIT_L(8); PG8_BAR; PG8_WAIT_L(0); PG8_MMA(0, 0, At, B0); PG8_BAR; PG8_SCHED;
            PG8_LDB(B1, 1, 1); PG8_STAGE(PG8_SB(1, 0), b3, voffB);
            PG8_BAR; PG8_WAIT_L(0); PG8_MMA(0, 1, At, B1); PG8_BAR;
            PG8_LDA(At, 1, 1); PG8_STAGE(PG8_SA(1, 0), a3, voffA);
            PG8_BAR; PG8_WAIT_L(0); PG8_MMA(1, 0, At, B0); PG8_BAR; PG8_SCHED;
            PG8_STAGE(PG8_SB(1, 1), b3 + hstep, voffB);
            PG8_WAIT_V(6); PG8_BAR; PG8_MMA(1, 1, At, B1); PG8_BAR;
            }
        }
        if constexpr (ALIGN_EPI) { if (wr == 0) PG8_BAR; }
        if constexpr (!Epi::AFTER_DRAIN) { E(acc, cur, wr, wc, fr, fq); S.done(cur); }
        if (!has_next) break;
#pragma unroll
        for (int a = 0; a < 2; ++a)
#pragma unroll
            for (int b = 0; b < 2; ++b)
#pragma unroll
                for (int m = 0; m < 4; ++m)
#pragma unroll
                    for (int n = 0; n < 2; ++n) acc[a][b][m][n] = (f32x4){0.f, 0.f, 0.f, 0.f};
        cur = nxt; cA = nA; cB = nB; ++ui;
        if constexpr (ALIGN_EPI) { if (wr == 1) PG8_BAR; }
    }
    PG8_WAIT_V(0);
    if constexpr (!ALIGN_EPI) { if (wr == 0) PG8_BAR; }
    PG8_BAR;
    if constexpr (Epi::AFTER_DRAIN) { E.fused(acc, cur, wr, wc, fr, fq, lds, wid, lane); S.done(cur); }
#undef PG8_SA
#undef PG8_SB
#undef PG8_STAGE
#undef PG8_LDA
#undef PG8_LDB
#undef PG8_MMA
#undef PG8_WAIT_V
#undef PG8_WAIT_L
#undef PG8_BAR
#undef PG8_SCHED
}
}
#ifndef REP_SCAN
#define REP_SCAN 1
#endif
#ifndef REP_ATTN
#define REP_ATTN 1
#endif
#ifndef REP_HELP
#define REP_HELP 1
#endif
#ifndef REP_P4
#define REP_P4 1
#endif
#ifndef REP_P1
#define REP_P1 1
#endif
#ifndef REP_P2
#define REP_P2 1
#endif
#ifndef REP_CHAIN
#define REP_CHAIN 1
#endif
#ifndef PG8_SP2
#define PG8_SP2 true
#endif
#ifndef PG8_ALIGN
#define PG8_ALIGN true
#endif
constexpr int NWAVES = 8;
constexpr int BATCH = 16, T = 4096, D = 1024, M = BATCH * T;
constexpr int INW = 2560, FF = 4096, NLORA = 1536, KLORA = 256;
constexpr int ZR0 = 768;
constexpr float RMS_EPS = 1e-6f, GN_EPS = 64e-5f;
constexpr size_t MiB = 1u << 20;
constexpr size_t WS_WIN = 2 * MiB, WS_WOUT = 8 * MiB, WS_WUP = 10 * MiB, WS_WDOWN = 18 * MiB, WS_BL = 26 * MiB, WS_LB = 27 * MiB;
constexpr size_t WS_MIX = 32 * MiB, WS_XN = 160 * MiB, WS_Z = 288 * MiB, WS_ALORA = 608 * MiB, WS_LORA = 640 * MiB, WS_H = 288 * MiB, WS_PB = 832 * MiB, WS_QB = 896 * MiB, WS_END = 960 * MiB;
constexpr int LDS_BYTES = 147456;

#define GAS __attribute__((address_space(1)))
#define LAS __attribute__((address_space(3)))
typedef unsigned short bf16;
typedef unsigned v4u __attribute__((ext_vector_type(4)));
typedef unsigned v2u __attribute__((ext_vector_type(2)));
typedef float f32x4 __attribute__((ext_vector_type(4)));
typedef float f32x2 __attribute__((ext_vector_type(2)));
typedef float f32x16 __attribute__((ext_vector_type(16)));
typedef short bf16x8 __attribute__((ext_vector_type(8)));
typedef short s16x4 __attribute__((ext_vector_type(4)));
#define LDS_WAIT() asm volatile("s_waitcnt lgkmcnt(0)" ::: "memory")
#define VM_WAIT() asm volatile("s_waitcnt vmcnt(0)" ::: "memory")
typedef __bf16 bf16x2_t __attribute__((ext_vector_type(2)));
__device__ __forceinline__ unsigned f2bf(float f) { return (unsigned)__builtin_bit_cast(unsigned short, (__bf16)f); }
__device__ __forceinline__ unsigned pk2(float lo, float hi) { const bf16x2_t v = __builtin_convertvector((f32x2){lo, hi}, bf16x2_t); return __builtin_bit_cast(unsigned, v); }
__device__ __forceinline__ float bf2f(unsigned short b) { return __builtin_bit_cast(float, (unsigned)b << 16); }
__device__ __forceinline__ float bflo(unsigned w) { return __builtin_bit_cast(float, w << 16); }
__device__ __forceinline__ float bfhi(unsigned w) { return __builtin_bit_cast(float, w & 0xffff0000u); }
__device__ __forceinline__ float wave_sum(float v) {
#pragma unroll
    for (int o = 1; o < 64; o <<= 1) v += __shfl_xor(v, o);
    return v;
}
template <int CTRL, int RM = 0xF> __device__ __forceinline__ float dppf(float v) { return __builtin_bit_cast(float, __builtin_amdgcn_update_dpp(0, __builtin_bit_cast(int, v), CTRL, RM, 0xF, true)); }
__device__ __forceinline__ float red16(float v) { v += dppf<0xB1>(v); v += dppf<0x4E>(v); v += dppf<0x141>(v); v += dppf<0x140>(v); return v; }
__device__ __forceinline__ float red4(float v) { v += dppf<0xB1>(v); v += dppf<0x4E>(v); return v; }
__device__ __forceinline__ float red8(float v) { v += dppf<0xB1>(v); v += dppf<0x4E>(v); v += dppf<0x141>(v); return v; }
__device__ __forceinline__ float wsum(float v) {
    v += dppf<0xB1>(v); v += dppf<0x4E>(v); v += dppf<0x141>(v); v += dppf<0x140>(v);
    v += dppf<0x142, 0xA>(v); v += dppf<0x143, 0xC>(v);
    return __builtin_bit_cast(float, __builtin_amdgcn_readlane(__builtin_bit_cast(int, v), 63));
}
__device__ __forceinline__ float sigmoidf_(float x) { return __builtin_amdgcn_rcpf(1.0f + __expf(-x)); }
#define WG_BAR_LDS() do { asm volatile("s_waitcnt lgkmcnt(0)" ::: "memory"); __builtin_amdgcn_s_barrier(); asm volatile("" ::: "memory"); } while (0)
__device__ __forceinline__ void wg_global_sync() { VM_WAIT(); __syncthreads(); __builtin_amdgcn_fence(__ATOMIC_ACQUIRE, "agent"); VM_WAIT(); }

struct Args { const float* in[20]; float* out; unsigned char* ws; };
#define RLX_AGENT __ATOMIC_RELAXED, __HIP_MEMORY_SCOPE_AGENT
#define XB_TMO      128
#define XB_XCNT(j)  (256  + 64 * (j))
#define XB_XSUB(j)  (1280 + 64 * (j))
#define XB_XGEN(j)  (2304 + 64 * (j))
#define XB_TOP      3328
#define XB_TOPGEN   3392
#define XCD_BAR_WORDS 3456
#define XB_SPIN_CAP (1u << 18)

__device__ __forceinline__ unsigned xb_ld(unsigned* p)              { return __hip_atomic_load(p, __ATOMIC_RELAXED, __HIP_MEMORY_SCOPE_AGENT); }
__device__ __forceinline__ unsigned xb_add(unsigned* p, unsigned v) { return __hip_atomic_fetch_add(p, v, __ATOMIC_RELAXED, __HIP_MEMORY_SCOPE_AGENT); }
__device__ __forceinline__ unsigned xb_xcc_id() { return (unsigned)__builtin_amdgcn_s_getreg((3 << 11) | 20) & 0xFu; }
#define XB_SPIN(cond, bar) do { unsigned _sp = 0; while (cond) { __builtin_amdgcn_s_sleep(1); \
    if ((++_sp & 255u) == 0u) { if (xb_ld(&(bar)[XB_TMO])) break; if (_sp > XB_SPIN_CAP) { atomicAdd(&(bar)[XB_TMO], 1u); break; } } } } while (0)

struct XcdBarrier {
    unsigned* bar; unsigned x;
    volatile LAS unsigned* st;
};

__device__ __forceinline__ XcdBarrier xcd_barrier_post(unsigned* bar, volatile LAS unsigned* st) {
    XcdBarrier b; b.bar = bar; b.x = xb_xcc_id(); b.st = st;
    if (threadIdx.x == 0) (void)xb_add(&bar[XB_XCNT(b.x)], 1u);
    return b;
}
__device__ __forceinline__ void xcd_barrier_complete(unsigned* bar, unsigned x, unsigned& nloc, unsigned& nx) {
    const unsigned G = gridDim.x * gridDim.y * gridDim.z;
    unsigned sum, cnt, mine, sp = 0u;
    for (;;) {
        sum = 0u; cnt = 0u; mine = 0u;
#pragma unroll
        for (unsigned j = 0; j < 16; ++j) { const unsigned c = xb_ld(&bar[XB_XCNT(j)]); sum += c; cnt += (c > 0u) ? 1u : 0u; mine = (j == x) ? c : mine; }
        if (sum == G) break;
        __builtin_amdgcn_s_sleep(1);
        if ((++sp & 255u) == 0u) { if (xb_ld(&bar[XB_TMO])) break; if (sp > XB_SPIN_CAP) { atomicAdd(&bar[XB_TMO], 1u); break; } }
    }
    nloc = mine > 0u ? mine : 1u; nx = cnt > 0u ? cnt : 1u;
}

__device__ __forceinline__ void xcd_barrier(const XcdBarrier& b) {
    asm volatile("s_waitcnt vmcnt(0)" ::: "memory");
    __syncthreads();
    if (threadIdx.x == 0) {
        unsigned* bar = b.bar;
        __builtin_amdgcn_s_waitcnt(0);
        unsigned nloc = b.st[0], nx = b.st[1];
        if (nloc == 0u) { xcd_barrier_complete(bar, b.x, nloc, nx); b.st[0] = nloc; b.st[1] = nx; }
        const unsigned old = xb_add(&bar[XB_XSUB(b.x)], 1u);
        const unsigned gen = old / nloc;
        if (old + 1u == (gen + 1u) * nloc) {
            __builtin_amdgcn_fence(__ATOMIC_RELEASE, "agent");
            asm volatile("s_waitcnt vmcnt(0)" ::: "memory");
            const unsigned og = xb_add(&bar[XB_TOP], 1u);
            const unsigned tg = og / nx;
            if (og + 1u == (tg + 1u) * nx) xb_add(&bar[XB_TOPGEN], 1u);
            else XB_SPIN(xb_ld(&bar[XB_TOPGEN]) == tg, bar);
            __builtin_amdgcn_fence(__ATOMIC_ACQUIRE, "agent");
            xb_add(&bar[XB_XGEN(b.x)], 1u);
            asm volatile("s_waitcnt vmcnt(0)" ::: "memory");
        } else {
            XB_SPIN(xb_ld(&bar[XB_XGEN(b.x)]) == gen, bar);
            __builtin_amdgcn_fence(__ATOMIC_ACQUIRE, "agent");
            asm volatile("s_waitcnt vmcnt(0)" ::: "memory");
        }
    }
    __syncthreads();
}

__device__ __forceinline__ void team_barrier(unsigned* cnt, unsigned np) {
    VM_WAIT(); __syncthreads();
    if (threadIdx.x == 0) {
        __builtin_amdgcn_fence(__ATOMIC_RELEASE, "agent"); VM_WAIT();
        __hip_atomic_fetch_add(cnt, 1u, __ATOMIC_RELAXED, __HIP_MEMORY_SCOPE_AGENT);
        unsigned sp = 0;
        while (__hip_atomic_load(cnt, __ATOMIC_RELAXED, __HIP_MEMORY_SCOPE_AGENT) < np) { __builtin_amdgcn_s_sleep(2); if (++sp > (1u << 22)) break; }
        __builtin_amdgcn_fence(__ATOMIC_ACQUIRE, "agent"); VM_WAIT();
    }
    __syncthreads();
}
__device__ __forceinline__ void p0_transpose_item(const float* W, int K, int N, bf16* WT, LAS float* scr, int item, int lane) {
    const int nblk = N / 32, kb = item / nblk, nb = item % nblk, k0 = 64 * kb, n0 = 32 * nb;
#pragma unroll 8
    for (int i = 0; i < 32; ++i) { const int kk = 2 * i + (lane >> 5); scr[kk * 33 + (lane & 31)] = W[(size_t)(k0 + kk) * N + n0 + (lane & 31)]; }
    LDS_WAIT(); asm volatile("" ::: "memory");
    const int c = lane & 7;
#pragma unroll
    for (int j = 0; j < 4; ++j) { const int n = (lane >> 3) + 8 * j; const LAS float* s = scr + (8 * c) * 33 + n;
        v4u o; o.x = pk2(s[0 * 33], s[1 * 33]); o.y = pk2(s[2 * 33], s[3 * 33]); o.z = pk2(s[4 * 33], s[5 * 33]); o.w = pk2(s[6 * 33], s[7 * 33]);
        *(GAS v4u*)(WT + (size_t)(n0 + n) * K + k0 + 8 * c) = o; }
    LDS_WAIT(); asm volatile("" ::: "memory");
}
template <int NR> __device__ __forceinline__ void rms_rows_to_bf16(const float* x0, size_t xstride, const float* g, bf16* o0, size_t ostride, int lane) {
    const GAS f32x4* gr = (const GAS f32x4*)g + lane;
    f32x4 v[NR][4]; float s[NR];
#pragma unroll
    for (int r = 0; r < NR; ++r) { const GAS f32x4* xr = (const GAS f32x4*)(x0 + r * xstride) + lane;
#pragma unroll
        for (int j = 0; j < 4; ++j) v[r][j] = xr[64 * j]; }
#pragma unroll
    for (int r = 0; r < NR; ++r) { float a = 0.f;
#pragma unroll
        for (int j = 0; j < 4; ++j) a += (v[r][j].x * v[r][j].x + v[r][j].y * v[r][j].y) + (v[r][j].z * v[r][j].z + v[r][j].w * v[r][j].w);
        s[r] = a; }
#pragma unroll
    for (int r = 0; r < NR; ++r) { const float rstd = __builtin_amdgcn_rsqf(wsum(s[r]) * (1.f / D) + RMS_EPS);
        GAS unsigned long long* o8 = (GAS unsigned long long*)(o0 + r * ostride) + lane;
#pragma unroll
        for (int j = 0; j < 4; ++j) { const f32x4 gg = gr[64 * j]; o8[64 * j] = (unsigned long long)pk2(v[r][j].x * rstd * gg.x, v[r][j].y * rstd * gg.y) | ((unsigned long long)pk2(v[r][j].z * rstd * gg.z, v[r][j].w * rstd * gg.w) << 32); } }
}
template <int NR> __device__ __forceinline__ void rms_rows_inplace(float* x0, size_t xstride, const float* g, int lane) {
    const GAS f32x4* gr = (const GAS f32x4*)g + lane;
    f32x4 v[NR][4]; float s[NR];
#pragma unroll
    for (int r = 0; r < NR; ++r) { const GAS f32x4* xr = (const GAS f32x4*)(x0 + r * xstride) + lane;
#pragma unroll
        for (int j = 0; j < 4; ++j) v[r][j] = xr[64 * j]; }
#pragma unroll
    for (int r = 0; r < NR; ++r) { float a = 0.f;
#pragma unroll
        for (int j = 0; j < 4; ++j) a += (v[r][j].x * v[r][j].x + v[r][j].y * v[r][j].y) + (v[r][j].z * v[r][j].z + v[r][j].w * v[r][j].w);
        s[r] = a; }
#pragma unroll
    for (int r = 0; r < NR; ++r) { const float rstd = __builtin_amdgcn_rsqf(wsum(s[r]) * (1.f / D) + RMS_EPS);
        GAS f32x4* xr = (GAS f32x4*)(x0 + r * xstride) + lane;
#pragma unroll
        for (int j = 0; j < 4; ++j) { const f32x4 gg = gr[64 * j]; xr[64 * j] = v[r][j] * rstd * gg; } }
}

__device__ __forceinline__ void lora_in_row(const bf16* Z, const float* mu, bf16* AL, int m, int lane) {
    const int c = 4 * lane;
    const v2u zc = *(const GAS v2u*)(Z + (size_t)m * INW + 2304 + c);
    const bool hasp = (m % T) != 0;
    const v2u zp = *(const GAS v2u*)(Z + (size_t)(hasp ? m - 1 : m) * INW + 2304 + c);
    const float fac = hasp ? 1.f : 0.f;
    const f32x4 mv = *(const GAS f32x4*)(mu + 1536 + c);
    float z[4] = {bflo(zc.x), bfhi(zc.x), bflo(zc.y), bfhi(zc.y)}, p[4] = {bflo(zp.x) * fac, bfhi(zp.x) * fac, bflo(zp.y) * fac, bfhi(zp.y) * fac}, o[4];
#pragma unroll
    for (int j = 0; j < 4; ++j) { const float v = z[j] + (p[j] - z[j]) * mv[j];
        o[j] = (c < 64) ? (1.f - 2.f / (1.f + __expf(2.f * v))) : ((c < 128) ? v : sigmoidf_(v)); }
    v2u w; w.x = pk2(o[0], o[1]); w.y = pk2(o[2], o[3]);
    *(GAS v2u*)(AL + (size_t)m * KLORA + c) = w;
}

constexpr int AT_KSTR = 144, AT_VSTR = 520, AT_VOFF = 256 * AT_KSTR;
__device__ __forceinline__ int crow(int r, int hi) { return (r & 3) + 8 * (r >> 2) + 4 * hi; }
__device__ __forceinline__ void attn_unit(LAS unsigned char* lds, const bf16* Z, bf16* MIX, const float* sinks, int b, int nb, int kvh) {
    const int tid = threadIdx.x, wid = __builtin_amdgcn_readfirstlane(tid >> 6), lane = tid & 63;
    __syncthreads();
#pragma unroll
    for (int i = 0; i < 4; ++i) {
        const int chunk = tid + 512 * i, key = chunk >> 3, c8 = chunk & 7, kpos = nb * 128 - 128 + key;
        v4u kv = (v4u){0u, 0u, 0u, 0u}, vv = (v4u){0u, 0u, 0u, 0u};
        if (kpos >= 0) { const bf16* zr = Z + (size_t)(b * T + kpos) * INW + 512 + kvh * 64 + c8 * 8; kv = *(const GAS v4u*)zr; vv = *(const GAS v4u*)(zr + 128); }
        *(LAS v4u*)(lds + key * AT_KSTR + c8 * 16) = kv;
        LAS unsigned short* vt = (LAS unsigned short*)(lds + AT_VOFF + (c8 * 8) * AT_VSTR + key * 2);
#pragma unroll
        for (int e = 0; e < 4; ++e) { vt[(2 * e) * (AT_VSTR / 2)] = (unsigned short)(vv[e] & 0xffffu); vt[(2 * e + 1) * (AT_VSTR / 2)] = (unsigned short)(vv[e] >> 16); }
    }
    __syncthreads();
    const int g = wid >> 1, hq = kvh * 4 + g, qhalf = wid & 1, q = lane & 31, hh = lane >> 5;
    const float slope = exp2f(-(float)(hq + 1)), sink = sinks[hq];
    for (int qt = 0; qt < 2; ++qt) {
        const int q0 = qhalf * 64 + qt * 32, qi = q0 + q, kt0 = q0 >> 5; const size_t m = (size_t)b * T + nb * 128 + qi;
        bf16x8 qf[4];
#pragma unroll
        for (int s = 0; s < 4; ++s) qf[s] = *(const GAS bf16x8*)(Z + m * INW + hq * 64 + 16 * s + 8 * hh);
        f32x16 sc[5];
#pragma unroll
        for (int i = 0; i < 5; ++i) {
#pragma unroll
            for (int r = 0; r < 16; ++r) sc[i][r] = 0.f;
#pragma unroll
            for (int s = 0; s < 4; ++s) { const bf16x8 a = *(const LAS bf16x8*)(lds + (32 * (kt0 + i) + q) * AT_KSTR + (16 * s + 8 * hh) * 2); sc[i] = __builtin_amdgcn_mfma_f32_32x32x16_bf16(a, qf[s], sc[i], 0, 0, 0); }
        }
        float mx = -1e30f;
#pragma unroll
        for (int i = 0; i < 5; ++i)
#pragma unroll
            for (int r = 0; r < 16; ++r) { const int kj = 32 * (kt0 + i) + crow(r, hh), dist = qi - kj + 128; const bool valid = (dist >= 0) && (dist < 128) && (nb * 128 - 128 + kj >= 0);
                const float v = valid ? (sc[i][r] * 0.125f - slope * (float)dist) : -1e30f; sc[i][r] = v; mx = fmaxf(mx, v); }
        mx = fmaxf(mx, __shfl_xor(mx, 32)); mx = fmaxf(mx, sink);
        float sum = 0.f;
#pragma unroll
        for (int i = 0; i < 5; ++i)
#pragma unroll
            for (int r = 0; r < 16; ++r) { const float e = __expf(sc[i][r] - mx); sc[i][r] = e; sum += e; }
        sum += __shfl_xor(sum, 32);
        const float inv = 1.0f / (sum + __expf(sink - mx));
        f32x16 o[2];
#pragma unroll
        for (int r = 0; r < 16; ++r) { o[0][r] = 0.f; o[1][r] = 0.f; }
#pragma unroll
        for (int i = 0; i < 5; ++i)
#pragma unroll
            for (int s = 0; s < 2; ++s) {
                v4u pw;
#pragma unroll
                for (int j = 0; j < 4; ++j) pw[j] = pk2(sc[i][8 * s + 2 * j] * inv, sc[i][8 * s + 2 * j + 1] * inv);
                const bf16x8 xs = __builtin_bit_cast(bf16x8, pw);
                const int kb = 32 * (kt0 + i) + 16 * s + 4 * hh;
#pragma unroll
                for (int dt = 0; dt < 2; ++dt) { const LAS unsigned char* vp = lds + AT_VOFF + (dt * 32 + q) * AT_VSTR + kb * 2;
                    const s16x4 lo = *(const LAS s16x4*)vp, hi = *(const LAS s16x4*)(vp + 16);
                    const bf16x8 pa = __builtin_shufflevector(lo, hi, 0, 1, 2, 3, 4, 5, 6, 7);
                    o[dt] = __builtin_amdgcn_mfma_f32_32x32x16_bf16(pa, xs, o[dt], 0, 0, 0); }
            }
        bf16* orow = MIX + m * D + hq * 64 + 4 * hh;
#pragma unroll
        for (int dt = 0; dt < 2; ++dt)
#pragma unroll
            for (int r4 = 0; r4 < 4; ++r4) { v2u w; w.x = pk2(o[dt][4 * r4], o[dt][4 * r4 + 1]); w.y = pk2(o[dt][4 * r4 + 2], o[dt][4 * r4 + 3]); *(GAS v2u*)(orow + dt * 32 + 8 * r4) = w; }
    }
}

constexpr int TC = 16, NCH = T / TC;
constexpr int SC_W = 0, SC_A = TC * 64, SC_B = 2 * TC * 64, SC_K = 3 * TC * 64, SC_R = 4 * TC * 64, SC_V = 5 * TC * 64, SC_G = 6 * TC * 64, SC_BON = 7 * TC * 64, SC_YP = 7 * TC * 64 + 64, SC_BUF = SC_YP + TC * 32 * 4;
static_assert(2 * SC_BUF * 4 <= 131072, "scan LDS");
struct ScanConst { f32x4 mu_r, mu_k, mu_v, kk, ka, rk; };
struct ScanRaw { v2u zr[3], zp[3], lo[3], lp; float fac, fac2; };
__device__ __forceinline__ f32x4 unpack4(v2u p) { return (f32x4){bflo(p.x), bfhi(p.x), bflo(p.y), bfhi(p.y)}; }
__device__ __forceinline__ float sum4(f32x4 v) { return (v.x + v.y) + (v.z + v.w); }
__device__ __forceinline__ void scan_load(ScanRaw& R, const bf16* Z, const bf16* LORA, int b, int h, int t0, int k4, int lane) {
    const int t = 4 * k4 + (lane >> 4), hc = h * 64 + 4 * (lane & 15); const size_t m = (size_t)b * T + t0 + t; const bool hasp = (t0 + t) > 0; R.fac = hasp ? 1.f : 0.f;
    const bool inchunk = t > 0; R.fac2 = inchunk ? 1.f : 0.f;
    const bf16* zrow = Z + m * INW + ZR0 + hc; const bf16* prow = hasp ? zrow - INW : zrow; const bf16* lrow = LORA + m * NLORA + hc;
#pragma unroll
    for (int j = 0; j < 3; ++j) { R.zr[j] = *(const GAS v2u*)(zrow + 512 * j); R.zp[j] = *(const GAS v2u*)(prow + 512 * j); R.lo[j] = *(const GAS v2u*)(lrow + 512 * j); }
    R.lp = *(const GAS v2u*)(inchunk ? lrow - NLORA : lrow);
}
__device__ __forceinline__ void scan_store(LAS float* buf, const ScanRaw& R, int k4, int lane, const ScanConst& c) {
    const int t = 4 * k4 + (lane >> 4), cg = lane & 15;
    const f32x4 zr = unpack4(R.zr[0]), zk = unpack4(R.zr[1]), zv = unpack4(R.zr[2]);
    const f32x4 xr = zr + (unpack4(R.zp[0]) * R.fac - zr) * c.mu_r, xk = zk + (unpack4(R.zp[1]) * R.fac - zk) * c.mu_k, xv = zv + (unpack4(R.zp[2]) * R.fac - zv) * c.mu_v;
    const f32x4 L = unpack4(R.lo[0]), Lp = unpack4(R.lp) * R.fac2, a = unpack4(R.lo[1]), g = unpack4(R.lo[2]);
    f32x4 eP, ePm, eN;
#pragma unroll
    for (int e = 0; e < 4; ++e) { eP[e] = __expf(L[e]); ePm[e] = __expf(Lp[e]); eN[e] = __builtin_amdgcn_rcpf(eP[e]); }
    const f32x4 kkr = xk * c.kk; const float ss = red16(sum4(kkr * kkr)); const f32x4 kk = kkr * __builtin_amdgcn_rsqf(fmaxf(ss, 1e-24f));
    const f32x4 k = xk * (1.f + (a - 1.f) * c.ka);
    const float bon = red16(sum4(xr * k * c.rk));
    *(LAS f32x4*)(buf + SC_A + t * 64 + 4 * cg) = -(kk * ePm); *(LAS f32x4*)(buf + SC_B + t * 64 + 4 * cg) = kk * a * eN; *(LAS f32x4*)(buf + SC_K + t * 64 + 4 * cg) = k * eN;
    *(LAS f32x4*)(buf + SC_R + t * 64 + 4 * cg) = xr * eP; *(LAS f32x4*)(buf + SC_V + t * 64 + 4 * cg) = xv; *(LAS f32x4*)(buf + SC_G + t * 64 + 4 * cg) = g; if (cg == 0) buf[SC_BON + t] = bon;
    if (t == TC - 1) *(LAS f32x4*)(buf + SC_W + 4 * cg) = eP;
}
__device__ __forceinline__ void scan_output(const LAS float* buf, float* Y, bf16* PB, bf16* QB, int b, int h, int half, int t0, int k4, int lane, f32x2 lnw2, f32x2 lnb2) {
    const int t = 4 * k4 + (lane >> 4), cg = lane & 15, row = half * 32 + 2 * cg; const size_t m = (size_t)b * T + t0 + t;
    const LAS f32x4* yp = (const LAS f32x4*)(buf + SC_YP + (t * 32 + 2 * cg) * 4);
    f32x2 y; y.x = sum4(yp[0]); y.y = sum4(yp[1]);
    const f32x2 v = *(const LAS f32x2*)(buf + SC_V + t * 64 + row), g = *(const LAS f32x2*)(buf + SC_G + t * 64 + row);
    const float bon = buf[SC_BON + t];
    const f32x2 P = g * lnw2, Q = (lnb2 + v * bon) * g;
    const size_t off = m * 512 + h * 64 + row;
    *(GAS f32x2*)(Y + off) = y; *(GAS unsigned*)(PB + off) = pk2(P.x, P.y); *(GAS unsigned*)(QB + off) = pk2(Q.x, Q.y);
}
struct ScanOps { f32x4 a, b, k, r; float v0, v1; };
__device__ __forceinline__ void scan_ops_load(ScanOps& o, const LAS float* buf, int t, int slice, int vrow) {
    o.a = *(const LAS f32x4*)(buf + SC_A + t * 64 + slice * 4); o.b = *(const LAS f32x4*)(buf + SC_B + t * 64 + slice * 4);
    o.k = *(const LAS f32x4*)(buf + SC_K + t * 64 + slice * 4); o.r = *(const LAS f32x4*)(buf + SC_R + t * 64 + slice * 4);
    o.v0 = buf[SC_V + t * 64 + vrow]; o.v1 = buf[SC_V + t * 64 + vrow + 16];
}
__device__ __forceinline__ void scan_steps(LAS float* buf, f32x2 (&S0)[2], f32x2 (&S1)[2], int slice, int rq, int vrow) {
    ScanOps cur; scan_ops_load(cur, buf, 0, slice, vrow);
    const f32x4 pc = *(const LAS f32x4*)(buf + SC_W + slice * 4);
    float yp0 = 0.f, yp1 = 0.f;
#pragma unroll
    for (int t = 0; t < TC; ++t) {
        ScanOps nxt; if (t + 1 < TC) scan_ops_load(nxt, buf, t + 1, slice, vrow);
        __builtin_amdgcn_sched_barrier(0);
        const f32x2 a[2] = {cur.a.xy, cur.a.zw}, bb[2] = {cur.b.xy, cur.b.zw}, k[2] = {cur.k.xy, cur.k.zw}, r[2] = {cur.r.xy, cur.r.zw};
        const f32x2 d0 = S0[0] * a[0] + S0[1] * a[1], d1 = S1[0] * a[0] + S1[1] * a[1];
        const f32x2 v0v = {cur.v0, cur.v0}, v1v = {cur.v1, cur.v1};
        f32x2 T0[2], T1[2];
#pragma unroll
        for (int q = 0; q < 2; ++q) { T0[q] = S0[q] + v0v * k[q]; T1[q] = S1[q] + v1v * k[q]; }
        asm volatile("" : "+v"(T0[0]), "+v"(T0[1]), "+v"(T1[0]), "+v"(T1[1]));
        float e0 = d0.x + d0.y, e1 = d1.x + d1.y;
        e0 += dppf<0xB1>(e0); e1 += dppf<0xB1>(e1); yp0 += dppf<0xB1>(yp0); yp1 += dppf<0xB1>(yp1);
        e0 += dppf<0x4E>(e0); e1 += dppf<0x4E>(e1); yp0 += dppf<0x4E>(yp0); yp1 += dppf<0x4E>(yp1);
        e0 += dppf<0x141>(e0); e1 += dppf<0x141>(e1);
        if (t > 0) { buf[SC_YP + ((t - 1) * 32 + rq) * 4 + (slice >> 2)] = yp0; buf[SC_YP + ((t - 1) * 32 + rq + 16) * 4 + (slice >> 2)] = yp1; }
        e0 += dppf<0x140>(e0); e1 += dppf<0x140>(e1);
        const f32x2 sa0v = {e0, e0}, sa1v = {e1, e1};
#pragma unroll
        for (int q = 0; q < 2; ++q) { S0[q] = T0[q] + sa0v * bb[q]; S1[q] = T1[q] + sa1v * bb[q]; }
        const f32x2 y0 = S0[0] * r[0] + S0[1] * r[1], y1 = S1[0] * r[0] + S1[1] * r[1];
        yp0 = y0.x + y0.y; yp1 = y1.x + y1.y;
        __builtin_amdgcn_sched_barrier(0);
        if (t + 1 < TC) cur = nxt;
    }
    S0[0] *= pc.xy; S0[1] *= pc.zw; S1[0] *= pc.xy; S1[1] *= pc.zw;
    yp0 = red4(yp0); yp1 = red4(yp1);
    buf[SC_YP + ((TC - 1) * 32 + rq) * 4 + (slice >> 2)] = yp0; buf[SC_YP + ((TC - 1) * 32 + rq + 16) * 4 + (slice >> 2)] = yp1;
}
__device__ __forceinline__ void scan_unit(LAS float* lds, const bf16* Z, const bf16* LORA, float* Y, bf16* PB, bf16* QB, const Args& args, int b, int h, int half) {
    const int tid = threadIdx.x, wid = __builtin_amdgcn_readfirstlane(tid >> 6), lane = tid & 63;
    __syncthreads();
    if (wid < 4) {
        const int slice = tid & 15, rq = tid >> 4, vrow = half * 32 + rq;
        f32x2 S0[2], S1[2];
#pragma unroll
        for (int q = 0; q < 2; ++q) { S0[q] = (f32x2){0.f, 0.f}; S1[q] = (f32x2){0.f, 0.f}; }
        WG_BAR_LDS();
        for (int ch = 0; ch < NCH; ++ch) { scan_steps(lds + (ch & 1) * SC_BUF, S0, S1, slice, rq, vrow); WG_BAR_LDS(); }
    } else {
        const int k4 = wid - 4, hc4 = h * 64 + 4 * (lane & 15), row = h * 64 + half * 32 + 2 * (lane & 15);
        ScanConst c; c.mu_r = *(const GAS f32x4*)(args.in[4] + hc4); c.mu_k = *(const GAS f32x4*)(args.in[4] + 512 + hc4); c.mu_v = *(const GAS f32x4*)(args.in[4] + 1024 + hc4);
        c.kk = *(const GAS f32x4*)(args.in[10] + hc4); c.ka = *(const GAS f32x4*)(args.in[11] + hc4); c.rk = *(const GAS f32x4*)(args.in[12] + hc4);
        const f32x2 lnw2 = *(const GAS f32x2*)(args.in[13] + row), lnb2 = *(const GAS f32x2*)(args.in[14] + row);
        ScanRaw Re, Ro; scan_load(Re, Z, LORA, b, h, 0, k4, lane); scan_store(lds, Re, k4, lane, c); scan_load(Ro, Z, LORA, b, h, TC, k4, lane); scan_load(Re, Z, LORA, b, h, 2 * TC, k4, lane);
        WG_BAR_LDS();
        for (int ch = 0; ch < NCH; ch += 2) {
            {
                LAS float* oth = lds + SC_BUF;
                if (ch > 0) scan_output(oth, Y, PB, QB, b, h, half, (ch - 1) * TC, k4, lane, lnw2, lnb2);
                scan_store(oth, Ro, k4, lane, c);
                if (ch + 3 < NCH) scan_load(Ro, Z, LORA, b, h, (ch + 3) * TC, k4, lane);
                WG_BAR_LDS();
            }
            {
                LAS float* oth = lds;
                scan_output(oth, Y, PB, QB, b, h, half, ch * TC, k4, lane, lnw2, lnb2);
                if (ch + 2 < NCH) { scan_store(oth, Re, k4, lane, c); if (ch + 4 < NCH) scan_load(Re, Z, LORA, b, h, (ch + 4) * TC, k4, lane); }
                WG_BAR_LDS();
            }
        }
        scan_output(lds + ((NCH - 1) & 1) * SC_BUF, Y, PB, QB, b, h, half, (NCH - 1) * TC, k4, lane, lnw2, lnb2);
    }
    __syncthreads();
}
__device__ __forceinline__ void rwkv_post_panel(const float* Y, const bf16* PB, const bf16* QB, bf16* MIX, int pm, int wave, int lane) {
    const int tsub = lane >> 4, cg = lane & 15;
    for (int j0 = 0; j0 < 64; j0 += 4) {
        f32x4 y[4]; v2u p[4], q[4];
#pragma unroll
        for (int u = 0; u < 4; ++u) { const size_t off = (size_t)(pm * 256 + (j0 + u) * 4 + tsub) * 512 + wave * 64 + 4 * cg; y[u] = *(const GAS f32x4*)(Y + off); p[u] = *(const GAS v2u*)(PB + off); q[u] = *(const GAS v2u*)(QB + off); }
#pragma unroll
        for (int u = 0; u < 4; ++u) { const size_t m = (size_t)(pm * 256 + (j0 + u) * 4 + tsub);
            const float mean = red16(sum4(y[u])) * (1.f / 64.f); const f32x4 d = y[u] - mean; const float var = red16(sum4(d * d)) * (1.f / 64.f);
            const f32x4 o = d * __builtin_amdgcn_rsqf(var + GN_EPS) * unpack4(p[u]) + unpack4(q[u]);
            v2u pw; pw.x = pk2(o[0], o[1]); pw.y = pk2(o[2], o[3]);
            *(GAS v2u*)(MIX + m * D + 512 + wave * 64 + 4 * cg) = pw; }
    }
}

__global__ void __launch_bounds__(NWAVES * 64, 2) mk_fwd(Args args) {
    extern __shared__ __attribute__((aligned(16))) unsigned char lds_raw[];
    LAS unsigned char* lds = (LAS unsigned char*)lds_raw;
    cg::grid_group grid = cg::this_grid();
    volatile LAS unsigned* bar_st = (volatile LAS unsigned*)(lds + 131072 + 64);
    if (threadIdx.x == 0) { bar_st[0] = 0u; bar_st[1] = 0u; }
    __syncthreads();
    const int tid = threadIdx.x, lane = tid & 63, wave = __builtin_amdgcn_readfirstlane(tid >> 6);
    const int G = gridDim.x, bx = blockIdx.x;
    unsigned char* ws = args.ws;
    const float* x = args.in[0]; float* out = args.out;
    bf16* WIN = (bf16*)(ws + WS_WIN); bf16* WOUT = (bf16*)(ws + WS_WOUT); bf16* WUP = (bf16*)(ws + WS_WUP); bf16* WDOWN = (bf16*)(ws + WS_WDOWN); bf16* BL = (bf16*)(ws + WS_BL); float* LB = (float*)(ws + WS_LB);
    bf16* MIX = (bf16*)(ws + WS_MIX); float* Yb = (float*)(ws + WS_XN); bf16* PB = (bf16*)(ws + WS_PB); bf16* QB = (bf16*)(ws + WS_QB); bf16* XN = (bf16*)(ws + WS_XN); bf16* Zb = (bf16*)(ws + WS_Z); bf16* AL = (bf16*)(ws + WS_ALORA); bf16* LORA = (bf16*)(ws + WS_LORA); bf16* HB = (bf16*)(ws + WS_H);

    {
        LAS float* scr = (LAS float*)(lds + wave * 16384);
        const int gw = bx * NWAVES + wave, NGW = G * NWAVES;
        constexpr int I_IN = (D / 64) * (INW / 32), I_OUT = (D / 64) * (D / 32), I_UP = (D / 64) * (FF / 32), I_DN = (FF / 64) * (D / 32);
        constexpr int NITEMS = I_IN + I_OUT + I_UP + I_DN;
        for (int it = gw; it < NITEMS; it += NGW) {
            int r = it;
            if (r < I_IN) { p0_transpose_item(args.in[2], D, INW, WIN, scr, r, lane); continue; } r -= I_IN;
            if (r < I_OUT) { p0_transpose_item(args.in[15], D, D, WOUT, scr, r, lane); continue; } r -= I_OUT;
            if (r < I_UP) { p0_transpose_item(args.in[17], D, FF, WUP, scr, r, lane); continue; } r -= I_UP;
            p0_transpose_item(args.in[18], FF, D, WDOWN, scr, r, lane);
        }
        if (bx == 0) for (int i = tid; i < 32768; i += NWAVES * 64) ((unsigned*)ws)[i] = 0u;
        for (int idx = bx * (NWAVES * 64) + tid; idx < NLORA * KLORA; idx += G * NWAVES * 64) {
            const int n = idx / KLORA, k = idx % KLORA; float v = 0.f;
            if (n < 512) { if (k < 64) v = args.in[6][k * 512 + n]; }
            else if (n < 1024) { if (k >= 64 && k < 128) v = args.in[8][(k - 64) * 512 + (n - 512)]; }
            else { if (k >= 128) v = args.in[9][(k - 128) * 512 + (n - 1024)]; }
            BL[idx] = (bf16)f2bf(v);
        }
        for (int idx = bx * (NWAVES * 64) + tid; idx < NLORA; idx += G * NWAVES * 64) LB[idx] = idx < 512 ? args.in[5][idx] : (idx < 1024 ? args.in[7][idx - 512] : 0.f);
        for (int m = gw * 4; m < M; m += NGW * 4) rms_rows_to_bf16<4>(x + (size_t)m * D, D, args.in[1], XN + (size_t)m * D, D, lane);
    }
    grid.sync();
    const XcdBarrier xbar = xcd_barrier_post((unsigned*)ws + 16384, bar_st);
    for (int rep_ = 0; rep_ < REP_P1; ++rep_) {
        pg8::Gemm g{XN, WIN, M, INW, D};
        const int pr = (bx >> 3) & 1, pbase = (bx & ~8);
        pg8::TeamOrder S{pbase, 8, pr * 5, 2, 5};
        pg8::EpiBf16<0> E{Zb, INW, nullptr, 0, 0, 1.f};
        pg8::gemm_phase<pg8::EpiBf16<0>, pg8::TeamOrder, PG8_ALIGN, PG8_SP2>(lds, g, S, E);
    }
    xcd_barrier(xbar);
    if (bx < M / 256) { const int pm = bx;
        for (int r = wave * 4; r < 256; r += NWAVES * 4) {
#pragma unroll
            for (int q = 0; q < 4; ++q) lora_in_row(Zb, args.in[4], AL, pm * 256 + r + q, lane); }
        wg_global_sync();
        pg8::Gemm g{AL, BL, M, NLORA, KLORA}; pg8::PanelOrder S{pm, NLORA / 256};
        pg8::EpiBf16<3> E{LORA, NLORA, LB, 0, 0, 1.f};
#ifndef NO_P1B
        pg8::gemm_phase<pg8::EpiBf16<3>, pg8::PanelOrder, PG8_ALIGN, PG8_SP2>(lds, g, S, E);
#endif
    }
    xcd_barrier(xbar);
    {
        for (int u = bx; u < BATCH * 32 * 2; u += G) attn_unit(lds, Zb, MIX, args.in[3], u >> 6, (u >> 1) & 31, u & 1);
        for (int u = bx; u < BATCH * 16; u += G) scan_unit((LAS float*)lds, Zb, LORA, Yb, PB, QB, args, u >> 4, (u >> 1) & 7, u & 1);
    }
    xcd_barrier(xbar);
    if (bx < M / 256) { const int pm = bx;
        const int xq = bx & 7, role = (bx >> 3) & 3, q = bx >> 5, tp0 = q * 32 + xq; unsigned* tcnt = (unsigned*)ws + (size_t)(q * 8 + xq) * 256;
        rwkv_post_panel(Yb, PB, QB, MIX, pm, wave, lane);
        team_barrier(tcnt, 4u);
        { pg8::Gemm g{MIX, WOUT, M, D, D}; pg8::TeamOrder S{tp0, 8, role, 4, 1}; pg8::EpiResF32 E{x, out, D};
          pg8::gemm_phase<pg8::EpiResF32, pg8::TeamOrder, PG8_ALIGN, PG8_SP2>(lds, g, S, E); }
        team_barrier(tcnt + 32, 4u);
        for (int r = wave * 4; r < 256; r += NWAVES * 4) rms_rows_to_bf16<4>(out + (size_t)(pm * 256 + r) * D, D, args.in[16], XN + (size_t)(pm * 256 + r) * D, D, lane);
        team_barrier(tcnt + 64, 4u);
        { pg8::Gemm g{XN, WUP, M, FF, D}; pg8::TeamOrder S{tp0, 8, role * 4, 4, 4}; pg8::EpiBf16<2> E{HB, FF, nullptr, 0, 0, 1.f};
          pg8::gemm_phase<pg8::EpiBf16<2>, pg8::TeamOrder, PG8_ALIGN, PG8_SP2>(lds, g, S, E); }
        team_barrier(tcnt + 96, 4u);
        { pg8::Gemm g{HB, WDOWN, M, D, FF}; pg8::TeamOrder S{tp0, 8, role, 4, 1}; pg8::EpiResF32 E{out, out, D};
          pg8::gemm_phase<pg8::EpiResF32, pg8::TeamOrder, PG8_ALIGN, PG8_SP2>(lds, g, S, E); }
        team_barrier(tcnt + 128, 4u);
        for (int r = wave * 4; r < 256; r += NWAVES * 4) rms_rows_inplace<4>(out + (size_t)(pm * 256 + r) * D, D, args.in[19], lane);
    }
}

extern "C" void kernel_launch(void* const* d_in, const int* in_sizes, int n_in, void* d_out, int out_size, void* d_ws, size_t ws_size, hipStream_t stream) {
    static int grid = 0;
    if (grid == 0) {
        if (n_in != 20 || in_sizes[0] != M * D || out_size != M * D || ws_size < WS_END) { fprintf(stderr, "kernel_launch: unexpected shapes (n_in %d, in0 %d, out %d, ws %zu)\n", n_in, n_in > 0 ? in_sizes[0] : -1, out_size, ws_size); grid = -1; return; }
        int dev = 0, cus = 0, per_cu = 0;
        if (hipGetDevice(&dev) != hipSuccess || hipDeviceGetAttribute(&cus, hipDeviceAttributeMultiprocessorCount, dev) != hipSuccess) { grid = -1; return; }
        if (hipFuncSetAttribute((const void*)mk_fwd, hipFuncAttributeMaxDynamicSharedMemorySize, LDS_BYTES) != hipSuccess) { fprintf(stderr, "kernel_launch: hipFuncSetAttribute failed\n"); grid = -1; return; }
        if (hipOccupancyMaxActiveBlocksPerMultiprocessor(&per_cu, (const void*)mk_fwd, NWAVES * 64, LDS_BYTES) != hipSuccess || per_cu < 1) { fprintf(stderr, "kernel_launch: occupancy query says %d\n", per_cu); (void)hipGetLastError(); per_cu = 1; }
        if (cus < M / 256) { fprintf(stderr, "kernel_launch: needs >= 256 CUs\n"); grid = -1; return; }
        grid = M / 256;
    }
    if (grid < 0) return;
    Args a{};
    for (int i = 0; i < 20; ++i) a.in[i] = (const float*)d_in[i];
    a.out = (float*)d_out; a.ws = (unsigned char*)d_ws;
    void* kargs[] = {&a};
    hipError_t e = hipLaunchCooperativeKernel((const void*)mk_fwd, dim3(grid), dim3(NWAVES * 64), kargs, LDS_BYTES, stream);
    if (e != hipSuccess) fprintf(stderr, "kernel_launch: cooperative launch failed: %s (grid %d)\n", hipGetErrorString(e), grid);
}
```
